# Optimizing an MI355X kernel written in HIP

```python
import math
import jax, jax.numpy as jnp
from jax import lax
import numpy as np

D_MODEL = 1024
BATCH = 8
SEQ = 2048
DEPTH = 4
DEC_BATCH = 128
DEC_SEQ = 1
PAST_LEN = 16384
PAGE_SIZE = 128

MIX_WIDTH = D_MODEL
HG_WIDTH = 3 * D_MODEL // 8
HG_DK = 64
HG_DV = 64
HG_HEADS = HG_WIDTH // HG_DV
RET_WIDTH = 3 * D_MODEL // 8
RET_DV = 64
RET_HEADS = RET_WIDTH // RET_DV
RET_DK = RET_DV // 2
RET_QK = RET_HEADS * RET_DK
S5_WIDTH = MIX_WIDTH - HG_WIDTH - RET_WIDTH
S5_GROUP = 16
S5_GROUPS = S5_WIDTH // S5_GROUP
S5_STATE = 64
D_FF = 4 * D_MODEL
IN_WIDTH = 4 * HG_WIDTH + 2 * RET_QK + 2 * RET_WIDTH + S5_WIDTH
CHUNK = 16
ROPE_BASE = 10000.0
EPS = 1e-5
ALPHA = (2.0 * DEPTH) ** 0.25
BETA = (8.0 * DEPTH) ** -0.25

kernel_name = "hymba_hgrn2_retnet_s5_deepnorm_step"


def _layer_norm(x, w, b):
    xf = x.astype(jnp.float32)
    mu = jnp.mean(xf, -1, keepdims=True)
    var = jnp.mean(jnp.square(xf - mu), -1, keepdims=True)
    return ((xf - mu) * lax.rsqrt(var + EPS) * w + b).astype(x.dtype)


def _rotary(x, pos):
    half = x.shape[-1] // 2
    inv = ROPE_BASE ** (-jnp.arange(half, dtype=jnp.float32) / half)
    ang = pos[:, None] * inv[None, :]
    cos = jnp.cos(ang)[:, None, :]
    sin = jnp.sin(ang)[:, None, :]
    x1, x2 = x[..., :half], x[..., half:]
    return jnp.concatenate([x1 * cos - x2 * sin, x1 * sin + x2 * cos], axis=-1)


def _chunked_gated_linear(q, k, v, log_f, s0):
    bsz, t, h, _ = q.shape
    dv = v.shape[-1]
    q, k, v, log_f = [a.astype(jnp.float32) for a in (q, k, v, log_f)]
    pad = (-t) % CHUNK
    if pad:
        cfg = ((0, 0), (0, pad), (0, 0), (0, 0))
        q, k, v, log_f = [jnp.pad(a, cfg) for a in (q, k, v, log_f)]
    n = (t + pad) // CHUNK

    def chunks(a):
        return a.reshape(bsz, n, CHUNK, h, a.shape[-1])

    q, k, v, log_f = chunks(q), chunks(k), chunks(v), chunks(log_f)
    b = jnp.cumsum(log_f, axis=2)
    causal = jnp.tril(jnp.ones((CHUNK, CHUNK), dtype=bool))[None, None, :, :, None, None]
    diff = b[:, :, :, None] - b[:, :, None, :]
    rel = jnp.where(causal, jnp.exp(jnp.where(causal, diff, 0.0)), 0.0)
    scores = jnp.einsum('bntshk,bnthk,bnshk->bnhts', rel, q, k)
    o_intra = jnp.einsum('bnhts,bnshv->bnthv', scores, v)
    q_dec = q * jnp.exp(b)
    k_dec = k * jnp.exp(b[:, :, -1:] - b)
    chunk_decay = jnp.exp(b[:, :, -1])

    def step(state, inp):
        qd, kd, vc, cd = inp
        o = jnp.einsum('bthk,bhkv->bthv', qd, state)
        state = cd[..., None] * state + jnp.einsum('bshk,bshv->bhkv', kd, vc)
        return state, o

    xs = tuple(jnp.moveaxis(a, 1, 0) for a in (q_dec, k_dec, v, chunk_decay))
    s_final, o_inter = lax.scan(step, s0.astype(jnp.float32), xs)
    o = o_intra + jnp.moveaxis(o_inter, 0, 1)
    o = o.reshape(bsz, n * CHUNK, h, dv)[:, :t]
    return o, s_final.astype(s0.dtype)


def _s5_combine(e1, e2):
    a1r, a1i, b1r, b1i = e1
    a2r, a2i, b2r, b2i = e2
    return (a2r * a1r - a2i * a1i,
            a2r * a1i + a2i * a1r,
            a2r * b1r - a2i * b1i + b2r,
            a2r * b1i + a2i * b1r + b2i)


def _s5_scan(u, log_dt, a_re, a_im, b_re, b_im, c_re, c_im, d, x0_re, x0_im):
    bsz, t, _ = u.shape
    f32 = jnp.float32
    uf = u.astype(f32).reshape(bsz, t, S5_GROUPS, S5_GROUP)
    a_re, a_im = a_re.astype(f32), a_im.astype(f32)
    dt = jnp.exp(log_dt.astype(f32))[:, None]
    mag = jnp.exp(dt * a_re)
    ab_re = mag * jnp.cos(dt * a_im)
    ab_im = mag * jnp.sin(dt * a_im)
    den = a_re * a_re + a_im * a_im
    nr = ab_re - 1.0
    g_re = (nr * a_re + ab_im * a_im) / den
    g_im = (ab_im * a_re - nr * a_im) / den
    b_re, b_im = b_re.astype(f32), b_im.astype(f32)
    bb_re = g_re[..., None] * b_re - g_im[..., None] * b_im
    bb_im = g_re[..., None] * b_im + g_im[..., None] * b_re
    bu_re = jnp.einsum('btgc,gnc->btgn', uf, bb_re)
    bu_im = jnp.einsum('btgc,gnc->btgn', uf, bb_im)
    x0r, x0i = x0_re.astype(f32), x0_im.astype(f32)
    bu_re = bu_re.at[:, 0].add(ab_re * x0r - ab_im * x0i)
    bu_im = bu_im.at[:, 0].add(ab_re * x0i + ab_im * x0r)
    ar = jnp.broadcast_to(ab_re, bu_re.shape)
    ai = jnp.broadcast_to(ab_im, bu_re.shape)
    _, _, xr, xi = lax.associative_scan(_s5_combine, (ar, ai, bu_re, bu_im), axis=1)
    y = (jnp.einsum('gcn,btgn->btgc', c_re.astype(f32), xr)
         - jnp.einsum('gcn,btgn->btgc', c_im.astype(f32), xi))
    y = y.reshape(bsz, t, S5_WIDTH) + d * uf.reshape(bsz, t, S5_WIDTH)
    return y, xr[:, -1].astype(x0_re.dtype), xi[:, -1].astype(x0_im.dtype)


def _layer(x, pos, s_hg, s_rt, s_re, s_im, w_in, lb, hg_norm_w, ret_norm_w,
           s5_log_dt, s5_a_re, s5_a_im, s5_b_re, s5_b_im, s5_c_re, s5_c_im, s5_d,
           s5_glu_w, s5_glu_b, w_out, ln1_w, ln1_b, w_up, w_down, ln2_w, ln2_b):
    f32 = jnp.float32
    bsz, t, _ = x.shape
    proj = jnp.einsum('btd,de->bte', x, w_in)
    sizes = [HG_WIDTH] * 4 + [RET_QK] * 2 + [RET_WIDTH] * 2 + [S5_WIDTH]
    cuts = [int(c) for c in np.cumsum(sizes)[:-1]]
    hq, hf, hi, hg, rq, rk, rv, rg, su = jnp.split(proj, cuts, axis=-1)

    def heads(a, nh):
        return a.reshape(bsz, t, nh, -1)

    lbf = lb.astype(f32)
    zf = hf.astype(f32)
    f_gate = lbf + (1.0 - lbf) * jax.nn.sigmoid(zf)
    log_f = jnp.log(f_gate)
    k_hg = (1.0 - lbf) * jax.nn.sigmoid(-zf)
    o_hg, s_hg_new = _chunked_gated_linear(heads(jax.nn.silu(hq), HG_HEADS), heads(k_hg, HG_HEADS),
                                           heads(hi, HG_HEADS), heads(log_f, HG_HEADS), s_hg)
    o_hg = o_hg * lax.rsqrt(jnp.mean(jnp.square(o_hg), -1, keepdims=True) + EPS)
    o_hg = o_hg * hg_norm_w * jax.nn.silu(heads(hg, HG_HEADS).astype(f32))
    o_hg = o_hg.reshape(bsz, t, HG_WIDTH)

    q_r = _rotary(heads(rq, RET_HEADS).astype(f32), pos)
    k_r = _rotary(heads(rk, RET_HEADS).astype(f32), pos) * (RET_DK ** -0.5)
    log_gamma = jnp.log1p(-jnp.exp2(-5.0 - jnp.arange(RET_HEADS, dtype=f32)))
    log_f_r = jnp.broadcast_to(log_gamma[:, None], (bsz, t, RET_HEADS, RET_DK))
    o_rt, s_rt_new = _chunked_gated_linear(q_r, k_r, heads(rv, RET_HEADS), log_f_r, s_rt)
    mu = jnp.mean(o_rt, -1, keepdims=True)
    var = jnp.mean(jnp.square(o_rt - mu), -1, keepdims=True)
    o_rt = (o_rt - mu) * lax.rsqrt(var + EPS) * ret_norm_w.reshape(RET_HEADS, RET_DV)
    o_rt = o_rt * jax.nn.silu(heads(rg, RET_HEADS).astype(f32))
    o_rt = o_rt.reshape(bsz, t, RET_WIDTH)

    y5, s_re_new, s_im_new = _s5_scan(su, s5_log_dt, s5_a_re, s5_a_im, s5_b_re, s5_b_im,
                                      s5_c_re, s5_c_im, s5_d, s_re, s_im)
    y5 = jax.nn.gelu(y5)
    y5 = y5 * jax.nn.sigmoid(y5 @ s5_glu_w + s5_glu_b)

    mixed = jnp.concatenate([o_hg, o_rt, y5], axis=-1).astype(x.dtype) @ w_out
    x = _layer_norm(ALPHA * x + mixed, ln1_w, ln1_b)
    ff = jnp.square(jax.nn.relu(x @ w_up)) @ w_down
    x = _layer_norm(ALPHA * x + ff, ln2_w, ln2_b)
    return x, s_hg_new, s_rt_new, s_re_new, s_im_new


def setup_inputs(seed: int = 0) -> dict:
    key = jax.random.key(seed)
    ks = jax.random.split(key, 32)
    f32 = jnp.float32

    def nrm(k, shape, scale):
        return scale * jax.random.normal(k, shape, f32)

    n_idx = jnp.arange(S5_STATE, dtype=f32)
    return {
        "x_prompt": nrm(ks[0], (BATCH, SEQ, D_MODEL), 1.0),
        "x_sample": nrm(ks[1], (DEC_BATCH, DEC_SEQ, D_MODEL), 1.0),
        "state_hgrn": nrm(ks[2], (DEPTH, DEC_BATCH, HG_HEADS, HG_DK, HG_DV), 0.3),
        "state_ret": nrm(ks[3], (DEPTH, DEC_BATCH, RET_HEADS, RET_DK, RET_DV), 1.0),
        "state_s5_re": nrm(ks[4], (DEPTH, DEC_BATCH, S5_GROUPS, S5_STATE), 0.3),
        "state_s5_im": nrm(ks[5], (DEPTH, DEC_BATCH, S5_GROUPS, S5_STATE), 0.3),
        "w_in": nrm(ks[6], (DEPTH, D_MODEL, IN_WIDTH), D_MODEL ** -0.5),
        "hgrn_lb_logits": nrm(ks[7], (DEPTH, HG_WIDTH), 0.1),
        "hgrn_norm_w": 1.0 + nrm(ks[8], (DEPTH, HG_DV), 0.02),
        "ret_norm_w": 1.0 + nrm(ks[9], (DEPTH, RET_WIDTH), 0.02),
        "s5_log_dt": jax.random.uniform(ks[10], (DEPTH, S5_GROUPS), f32, math.log(1e-3), math.log(1e-1)),
        "s5_a_re": -0.5 + nrm(ks[11], (DEPTH, S5_GROUPS, S5_STATE), 0.01),
        "s5_a_im": math.pi * n_idx + nrm(ks[12], (DEPTH, S5_GROUPS, S5_STATE), 0.01),
        "s5_b_re": nrm(ks[13], (DEPTH, S5_GROUPS, S5_STATE, S5_GROUP), (2 * S5_GROUP) ** -0.5),
        "s5_b_im": nrm(ks[14], (DEPTH, S5_GROUPS, S5_STATE, S5_GROUP), (2 * S5_GROUP) ** -0.5),
        "s5_c_re": nrm(ks[15], (DEPTH, S5_GROUPS, S5_GROUP, S5_STATE), (2 * S5_STATE) ** -0.5),
        "s5_c_im": nrm(ks[16], (DEPTH, S5_GROUPS, S5_GROUP, S5_STATE), (2 * S5_STATE) ** -0.5),
        "s5_d": nrm(ks[17], (DEPTH, S5_WIDTH), 0.5),
        "s5_glu_w": nrm(ks[18], (DEPTH, S5_WIDTH, S5_WIDTH), S5_WIDTH ** -0.5),
        "s5_glu_b": nrm(ks[19], (DEPTH, S5_WIDTH), 0.01),
        "w_out": nrm(ks[20], (DEPTH, MIX_WIDTH, D_MODEL), BETA * MIX_WIDTH ** -0.5),
        "ln1_w": 1.0 + nrm(ks[21], (DEPTH, D_MODEL), 0.02),
        "ln1_b": nrm(ks[22], (DEPTH, D_MODEL), 0.02),
        "w_up": nrm(ks[23], (DEPTH, D_MODEL, D_FF), D_MODEL ** -0.5),
        "w_down": nrm(ks[24], (DEPTH, D_FF, D_MODEL), BETA * D_FF ** -0.5),
        "ln2_w": 1.0 + nrm(ks[25], (DEPTH, D_MODEL), 0.02),
        "ln2_b": nrm(ks[26], (DEPTH, D_MODEL), 0.02),
    }


def reference(x_prompt, x_sample, state_hgrn, state_ret, state_s5_re, state_s5_im,
              w_in, hgrn_lb_logits, hgrn_norm_w, ret_norm_w, s5_log_dt, s5_a_re, s5_a_im,
              s5_b_re, s5_b_im, s5_c_re, s5_c_im, s5_d, s5_glu_w, s5_glu_b, w_out,
              ln1_w, ln1_b, w_up, w_down, ln2_w, ln2_b):
    f32 = jnp.float32
    lb_prob = jax.nn.softmax(hgrn_lb_logits.astype(f32), axis=0)
    lower_bounds = jnp.cumsum(lb_prob, axis=0) - lb_prob[0:1]

    bp, tp, _ = x_prompt.shape
    pos_p = jnp.arange(tp, dtype=f32)
    pos_s = PAST_LEN + jnp.arange(x_sample.shape[1], dtype=f32)
    zero_hg = jnp.zeros((bp, HG_HEADS, HG_DK, HG_DV), f32)
    zero_rt = jnp.zeros((bp, RET_HEADS, RET_DK, RET_DV), f32)
    zero_s5 = jnp.zeros((bp, S5_GROUPS, S5_STATE), f32)

    yp, ys = x_prompt, x_sample
    hg_p, rt_p, re_p, im_p = [], [], [], []
    hg_s, rt_s, re_s, im_s = [], [], [], []
    for l in range(DEPTH):
        params = (w_in[l], lower_bounds[l], hgrn_norm_w[l], ret_norm_w[l], s5_log_dt[l],
                  s5_a_re[l], s5_a_im[l], s5_b_re[l], s5_b_im[l], s5_c_re[l], s5_c_im[l],
                  s5_d[l], s5_glu_w[l], s5_glu_b[l], w_out[l], ln1_w[l], ln1_b[l],
                  w_up[l], w_down[l], ln2_w[l], ln2_b[l])
        yp, a, b, c, d = _layer(yp, pos_p, zero_hg, zero_rt, zero_s5, zero_s5, *params)
        ys, e, f, g, h = _layer(ys, pos_s, state_hgrn[l], state_ret[l], state_s5_re[l],
                                state_s5_im[l], *params)
        hg_p.append(a); rt_p.append(b); re_p.append(c); im_p.append(d)
        hg_s.append(e); rt_s.append(f); re_s.append(g); im_s.append(h)

    new_hgrn_prompt = jnp.stack(hg_p)
    new_ret_prompt = jnp.stack(rt_p)
    new_s5_re_prompt = jnp.stack(re_p)
    new_s5_im_prompt = jnp.stack(im_p)
    new_hgrn_sample = jnp.stack(hg_s)
    new_ret_sample = jnp.stack(rt_s)
    new_s5_re_sample = jnp.stack(re_s)
    new_s5_im_sample = jnp.stack(im_s)
    return (yp, ys, new_hgrn_prompt, new_ret_prompt, new_s5_re_prompt, new_s5_im_prompt,
            new_hgrn_sample, new_ret_sample, new_s5_re_sample, new_s5_im_sample)
```

```cpp
#include <hip/hip_runtime.h>
#include <hip/hip_cooperative_groups.h>
#include <cstdio>
#include <cstdint>
namespace cg = cooperative_groups;
namespace pg8 {
#define PG8_LAS __attribute__((address_space(3)))
typedef unsigned short bf16_t;
typedef short bf16x8 __attribute__((ext_vector_type(8)));
typedef float f32x4 __attribute__((ext_vector_type(4)));
typedef unsigned u32x4 __attribute__((ext_vector_type(4)));
constexpr int BM = 256, BK = 64, HALF = 128, HTB = HALF * BK * 2  , STAGE_BYTES = 8 * HTB, NXCD = 8, WGM = 8;

__host__ __device__ __forceinline__ int lds_byte(int r, int c) { const int st = (r >> 4) * 2 + (c >> 5), rr = r & 15, cc = c & 31, ob = rr * 64 + cc * 2; return st * 1024 + (ob ^ (((ob >> 9) & 1) << 5)); }
__host__ __device__ __forceinline__ void stage_rc(int b, int& R, int& C) { const int st = b / 1024, sb = b % 1024, swz = sb ^ (((sb >> 9) & 1) << 5); R = (st >> 1) * 16 + swz / 64; C = (st & 1) * 32 + (swz % 64) / 2; }
__host__ __device__ __forceinline__ int perm32(int rho) { const int n = rho >> 4, i = rho & 15; return 8 * (i >> 2) + 4 * n + (i & 3); }

struct Unit { int pm, pn; };
struct Gemm { const bf16_t* A; const bf16_t* Bt; int M, N, K; };

struct StaticOrder {
    int nM, nN, nwg, G, c;
    __host__ __device__ void init(int M, int N, int G_, int c_) { nM = M / BM; nN = N / BM; nwg = nM * nN; G = G_; c = c_; }
    __host__ __device__ bool next(int i, Unit& u) const {
        const long L = (long)i * G + c; if (L >= nwg) return false;
        int wgid = (int)L; { const int q = nwg / NXCD, r = nwg % NXCD, xcd = wgid % NXCD, off = wgid / NXCD; wgid = (xcd < r ? xcd * (q + 1) : r * (q + 1) + (xcd - r) * q) + off; }
        const int nig = WGM * nN, gid = wgid / nig, fm = gid * WGM, gsz = (nM - fm) < WGM ? (nM - fm) : WGM;
        u.pm = fm + ((wgid % nig) % gsz); u.pn = (wgid % nig) / gsz; return true;
    }
    __device__ __forceinline__ void a_ready(const Unit&) const {}
    __device__ __forceinline__ void done(const Unit&) const {}
};
template <class Epi, class Sched, bool ALIGN_EPI = false, bool SP2 = false>
__device__ __forceinline__ void gemm_phase(PG8_LAS unsigned char* lds, const Gemm g, const Sched& S, const Epi& E, const int wid) {
    int lane_; asm volatile("v_mbcnt_lo_u32_b32 %0, -1, 0\n\tv_mbcnt_hi_u32_b32 %0, -1, %0" : "=v"(lane_));
    const int lane = lane_, tid = wid * 64 + lane, wr = wid >> 2, wc = wid & 3, fr = lane & 15, fq = lane >> 4;
    const int K = g.K, nt = K / BK;
    unsigned voffA[2], voffB[2];
#pragma unroll
    for (int i = 0; i < 2; ++i) { int R, C; stage_rc(tid * 16 + i * 8192, R, C); const int Rb = Epi::PERM ? ((R & ~31) + perm32(R & 31)) : R;
        voffA[i] = (unsigned)(R * K + C) * 2u; voffB[i] = (unsigned)(Rb * K + C) * 2u; }
    const size_t kstep = (size_t)(BK * 2);
    const size_t hstep = (size_t)HALF * K * 2;
    const size_t tstep = 2 * hstep;
    const unsigned ldsw = (unsigned)wid * 1024u;
    const int aoff = lds_byte(wr * 64 + fr, fq * 8), boff = lds_byte(wc * 32 + fr, fq * 8);
#define PG8_SA(b, h) (((b) * 2 + (h)) * HTB)
#define PG8_SB(b, h) ((4 + (b) * 2 + (h)) * HTB)
#define PG8_STAGE(bufoff, gbase, voff) do { _Pragma("unroll") for (int _i = 0; _i < 2; ++_i) \
        __builtin_amdgcn_global_load_lds((const unsigned*)((const char*)(gbase) + (voff)[_i]), (PG8_LAS unsigned*)(lds + (bufoff) + ldsw + _i * 8192), 16, 0, 0); } while (0)
#define PG8_LDA(dst, b, h) do { _Pragma("unroll") for (int m = 0; m < 4; ++m) _Pragma("unroll") for (int k = 0; k < 2; ++k) dst[m][k] = *(const PG8_LAS bf16x8*)(lds + PG8_SA(b, h) + aoff + m * 2048 + k * 1024); } while (0)
#define PG8_LDB(dst, b, h) do { _Pragma("unroll") for (int n = 0; n < 2; ++n) _Pragma("unroll") for (int k = 0; k < 2; ++k) dst[n][k] = *(const PG8_LAS bf16x8*)(lds + PG8_SB(b, h) + boff + n * 2048 + k * 1024); } while (0)
#define PG8_MMA(ai, bj, At, Bt) do { __builtin_amdgcn_s_setprio(1); _Pragma("unroll") for (int m = 0; m < 4; ++m) _Pragma("unroll") for (int n = 0; n < 2; ++n) _Pragma("unroll") for (int k = 0; k < 2; ++k) \
        acc[ai][bj][m][n] = __builtin_amdgcn_mfma_f32_16x16x32_bf16(Bt[n][k], At[m][k], acc[ai][bj][m][n], 0, 0, 0); __builtin_amdgcn_s_setprio(0); } while (0)
#define PG8_WAIT_V(n) asm volatile("s_waitcnt vmcnt(" #n ")" ::: "memory")
#define PG8_WAIT_L(n) asm volatile("s_waitcnt lgkmcnt(" #n ")" ::: "memory")
#define PG8_BAR __builtin_amdgcn_s_barrier()
#define PG8_SCHED __builtin_amdgcn_sched_barrier(0)
    Unit cur, nxt; int ui = 0;
    if (!S.next(0, cur)) return;
    f32x4 acc[2][2][4][2];
#pragma unroll
    for (int a = 0; a < 2; ++a)
#pragma unroll
        for (int b = 0; b < 2; ++b)
#pragma unroll
            for (int m = 0; m < 4; ++m)
#pragma unroll
                for (int n = 0; n < 2; ++n) acc[a][b][m][n] = (f32x4){0.f, 0.f, 0.f, 0.f};
    bf16x8 At[4][2], B0[2][2], B1[2][2];
    const char* cA = (const char*)g.A + (size_t)cur.pm * tstep; const char* cB = (const char*)g.Bt + (size_t)cur.pn * tstep;
    S.a_ready(cur);
    if constexpr (SP2) {
        PG8_STAGE(PG8_SB(0, 0), cB, voffB); PG8_STAGE(PG8_SB(0, 1), cB + hstep, voffB); PG8_STAGE(PG8_SA(0, 0), cA, voffA); PG8_STAGE(PG8_SA(0, 1), cA + hstep, voffA);
        if (wr == 1) PG8_BAR;
        PG8_WAIT_V(2); PG8_BAR;
        PG8_STAGE(PG8_SB(1, 0), cB + kstep, voffB); PG8_STAGE(PG8_SA(1, 0), cA + kstep, voffA); PG8_STAGE(PG8_SB(1, 1), cB + hstep + kstep, voffB);
        PG8_WAIT_V(6); PG8_BAR;
    } else {
        PG8_STAGE(PG8_SB(0, 0), cB, voffB); PG8_STAGE(PG8_SA(0, 0), cA, voffA); PG8_STAGE(PG8_SB(0, 1), cB + hstep, voffB); PG8_STAGE(PG8_SA(0, 1), cA + hstep, voffA);
        if (wr == 1) PG8_BAR;
        PG8_WAIT_V(4); PG8_BAR;
        PG8_STAGE(PG8_SB(1, 0), cB + kstep, voffB); PG8_STAGE(PG8_SA(1, 0), cA + kstep, voffA); PG8_STAGE(PG8_SB(1, 1), cB + hstep + kstep, voffB);
        PG8_WAIT_V(6); PG8_BAR;
    }
    for (;;) {
        const bool has_next = S.next(ui + 1, nxt);
        const char* nA = has_next ? (const char*)g.A + (size_t)nxt.pm * tstep : cA; const char* nB = has_next ? (const char*)g.Bt + (size_t)nxt.pn * tstep : cB;
        for (int t = 0; t < nt; t += 2) {
            const bool last = (t == nt - 2);
            const char* a1 = cA + (size_t)(t + 1) * kstep;
            const char* a2 = last ? nA : cA + (size_t)(t + 2) * kstep; const char* b2 = last ? nB : cB + (size_t)(t + 2) * kstep;
            const char* a3 = a2 + kstep; const char* b3 = b2 + kstep;
            if (last && has_next) S.a_ready(nxt);
            if constexpr (SP2) {
            PG8_LDB(B0, 0, 0); PG8_LDB(B1, 0, 1); PG8_SCHED; PG8_LDA(At, 0, 0); PG8_STAGE(PG8_SA(1, 1), a1 + hstep, voffA);
            PG8_WAIT_V(8); PG8_WAIT_L(0); PG8_BAR; PG8_MMA(0, 0, At, B0); PG8_MMA(0, 1, At, B1); PG8_BAR; PG8_SCHED;
            PG8_LDA(At, 0, 1); PG8_STAGE(PG8_SB(0, 0), b2, voffB); PG8_STAGE(PG8_SB(0, 1), b2 + hstep, voffB); PG8_STAGE(PG8_SA(0, 0), a2, voffA);
            PG8_WAIT_V(8); PG8_WAIT_L(0); PG8_BAR; PG8_MMA(1, 0, At, B0); PG8_MMA(1, 1, At, B1); PG8_BAR; PG8_SCHED;
            PG8_LDB(B0, 1, 0); PG8_LDB(B1, 1, 1); PG8_SCHED; PG8_LDA(At, 1, 0); PG8_STAGE(PG8_SA(0, 1), a2 + hstep, voffA);
            PG8_WAIT_V(8); PG8_WAIT_L(0); PG8_BAR; PG8_MMA(0, 0, At, B0); PG8_MMA(0, 1, At, B1); PG8_BAR; PG8_SCHED;
            PG8_LDA(At, 1, 1); PG8_STAGE(PG8_SB(1, 0), b3, voffB); PG8_STAGE(PG8_SB(1, 1), b3 + hstep, voffB); PG8_STAGE(PG8_SA(1, 0), a3, voffA);
            PG8_WAIT_V(8); PG8_WAIT_L(0); PG8_BAR; PG8_MMA(1, 0, At, B0); PG8_MMA(1, 1, At, B1); PG8_BAR; PG8_SCHED;
            } else {
            PG8_LDB(B0, 0, 0); PG8_SCHED; PG8_LDA(At, 0, 0); PG8_STAGE(PG8_SA(1, 1), a1 + hstep, voffA);
            PG8_WAIT_L(8); PG8_BAR; PG8_WAIT_L(0); PG8_MMA(0, 0, At, B0); PG8_BAR; PG8_SCHED;
            PG8_LDB(B1, 0, 1); PG8_STAGE(PG8_SB(0, 0), b2, voffB);
            PG8_BAR; PG8_WAIT_L(0); PG8_MMA(0, 1, At, B1); PG8_BAR;
            PG8_LDA(At, 0, 1); PG8_STAGE(PG8_SA(0, 0), a2, voffA);
            PG8_BAR; PG8_WAIT_L(0); PG8_MMA(1, 0, At, B0); PG8_BAR; PG8_SCHED;
            PG8_STAGE(PG8_SB(0, 1), b2 + hstep, voffB);
            PG8_WAIT_V(6); PG8_BAR; PG8_MMA(1, 1, At, B1); PG8_BAR;
            PG8_LDB(B0, 1, 0); PG8_SCHED; PG8_LDA(At, 1, 0); PG8_STAGE(PG8_SA(0, 1), a2 + hstep, voffA);
            PG8_WAIT_L(8); PG8_BAR; PG8_WAIT_L(0); PG8_MMA(0, 0, At, B0); PG8_BAR; PG8_SCHED;
            PG8_LDB(B1, 1, 1); PG8_STAGE(PG8_SB(1, 0), b3, voffB);
            PG8_BAR; PG8_WAIT_L(0); PG8_MMA(0, 1, At, B1); PG8_BAR;
            PG8_LDA(At, 1, 1); PG8_STAGE(PG8_SA(1, 0), a3, voffA);
            PG8_BAR; PG8_WAIT_L(0); PG8_MMA(1, 0, At, B0); PG8_BAR; PG8_SCHED;
            PG8_STAGE(PG8_SB(1, 1), b3 + hstep, voffB);
            PG8_WAIT_V(6); PG8_BAR; PG8_MMA(1, 1, At, B1); PG8_BAR;
            }
        }
        if constexpr (ALIGN_EPI) { if (wr == 0) PG8_BAR; }
        if constexpr (!Epi::AFTER_DRAIN) { int l_e; asm volatile("v_mbcnt_lo_u32_b32 %0, -1, 0\n\tv_mbcnt_hi_u32_b32 %0, -1, %0" : "=v"(l_e)); const int fr_e = l_e & 15, fq_e = l_e >> 4;
            E(acc, cur, wr, wc, fr_e, fq_e); S.done(cur); }
        if (!has_next) break;
#pragma unroll
        for (int a = 0; a < 2; ++a)
#pragma unroll
            for (int b = 0; b < 2; ++b)
#pragma unroll
                for (int m = 0; m < 4; ++m)
#pragma unroll
                    for (int n = 0; n < 2; ++n) acc[a][b][m][n] = (f32x4){0.f, 0.f, 0.f, 0.f};
        cur = nxt; cA = nA; cB = nB; ++ui;
        if constexpr (ALIGN_EPI) { if (wr == 1) PG8_BAR; }
    }
    PG8_WAIT_V(0);
    if constexpr (!ALIGN_EPI) { if (wr == 0) PG8_BAR; }
    PG8_BAR;
    if constexpr (Epi::AFTER_DRAIN) { E.fused(acc, cur, wr, wc, fr, fq, lds, wid, lane); S.done(cur); }
#undef PG8_SA
#undef PG8_SB
#undef PG8_STAGE
#undef PG8_LDA
#undef PG8_LDB
#undef PG8_MMA
#undef PG8_WAIT_V
#undef PG8_WAIT_L
#undef PG8_BAR
#undef PG8_SCHED
}
}

#define LAS __attribute__((address_space(3)))
#define DEVI __device__ __forceinline__
typedef unsigned short bf16_t;
typedef short bf16x8 __attribute__((ext_vector_type(8)));
typedef short bf16x4 __attribute__((ext_vector_type(4)));
typedef float f32x4 __attribute__((ext_vector_type(4)));
typedef float f32x2 __attribute__((ext_vector_type(2)));
typedef unsigned u32x4 __attribute__((ext_vector_type(4)));
typedef unsigned u32x2 __attribute__((ext_vector_type(2)));
typedef __bf16 bf16v2 __attribute__((ext_vector_type(2)));
using pg8::Unit;

constexpr int DM = 1024, NP = 16384, NS = 128, MT = NP + NS, SEQ = 2048, NBATCH = 8, DEPTH = 4;
constexpr int INW = 2944, INP = 3072, FF = 4096;
constexpr int C_HQ = 0, C_HF = 384, C_HI = 768, C_HGG = 1152, C_RQ = 1536, C_RK = 1728, C_RV = 1920, C_RG = 2304, C_SU = 2688;
constexpr float LN_EPS = 1e-5f;
constexpr float ALPHA = 1.6817928305074290f;
constexpr int NSEG = 32, SEGL = 64;
constexpr int NU_HG = NBATCH * 6 * NSEG, NU_RT = NBATCH * 6 * NSEG, NU_S5 = NBATCH * 16 * NSEG;

constexpr size_t O_YP = 0, O_YS = 16777216, O_HGP = 16908288, O_RTP = 17694720, O_S5RP = 18087936, O_S5IP = 18120704,
                 O_HGS = 18153472, O_RTS = 30736384, O_S5RS = 37027840, O_S5IS = 37552128;
constexpr size_t MiB = 1u << 20;
constexpr size_t WS_ROPE = 0, WS_LB = 0x48000, WS_APOW = 0x50000, WS_GT = 0xE0000, WS_BB = 0xF0000, WS_CM = 0x130000;
constexpr size_t WS_WIN = 2 * MiB, WS_WOUT = 26 * MiB, WS_WUP = 34 * MiB, WS_WDN = 66 * MiB, WS_WGLU = 98 * MiB;
constexpr size_t WS_XB = 99 * MiB, WS_PROJ = 132 * MiB, WS_MIX = WS_PROJ + (size_t)MT * INP * 2, WS_HID = WS_PROJ;
constexpr size_t WS_Y5 = 262 * MiB, WS_SHG = 271 * MiB, WS_DHG = 295 * MiB, WS_SRT = 296 * MiB, WS_XS5 = 308 * MiB, WS_END = 310 * MiB;
static_assert(WS_MIX + (size_t)MT * DM * 2 <= WS_Y5, "ws map");
constexpr int LDS_BYTES = 147456;

struct Args { const float* in[27]; float* out; unsigned char* ws; };

DEVI float bf2f(bf16_t b) { return __uint_as_float(((unsigned)b) << 16); }
DEVI unsigned pk2(float lo, float hi) { f32x2 v = {lo, hi}; bf16v2 b = __builtin_convertvector(v, bf16v2); return __builtin_bit_cast(unsigned, b); }
DEVI bf16_t f2bf1(float f) { return (bf16_t)(pk2(f, 0.f) & 0xffffu); }
DEVI bf16x4 cvt4(f32x4 v) { u32x2 w; w.x = pk2(v[0], v[1]); w.y = pk2(v[2], v[3]); return __builtin_bit_cast(bf16x4, w); }
DEVI float rcpf(float x) { return __builtin_amdgcn_rcpf(x); }
DEVI float siluf(float x) { return x * rcpf(1.f + __expf(-x)); }
template <int C> DEVI float dpp_f(float x) { return __int_as_float(__builtin_amdgcn_update_dpp(0, __float_as_int(x), C, 0xF, 0xF, false)); }
DEVI float row16_sum(float v) { v += dpp_f<0x128>(v); v += dpp_f<0x124>(v); v += dpp_f<0x122>(v); v += dpp_f<0x121>(v); return v; }
DEVI float rdlane(float v, int l) { return __int_as_float(__builtin_amdgcn_readlane(__float_as_int(v), l)); }
DEVI float wave_sum(float v) { v = row16_sum(v); return (rdlane(v, 0) + rdlane(v, 16)) + (rdlane(v, 32) + rdlane(v, 48)); }
DEVI float bperm(float v, int src) { return __int_as_float(__builtin_amdgcn_ds_bpermute(src << 2, __float_as_int(v))); }
template <int D> DEVI float dpp_shr(float x) { return __int_as_float(__builtin_amdgcn_update_dpp(0, __float_as_int(x), 0x110 + D, 0xF, 0xF, false)); }
#define MFMA16(a, b, c) __builtin_amdgcn_mfma_f32_16x16x16bf16_1k((a), (b), (c), 0, 0, 0)
#define LDSW() asm volatile("s_waitcnt lgkmcnt(0)" ::: "memory")
DEVI int hw_lane() { int l; asm volatile("v_mbcnt_lo_u32_b32 %0, -1, 0\n\tv_mbcnt_hi_u32_b32 %0, -1, %0" : "=v"(l)); return l; }

template <int ACT> struct EpiBf {
    static constexpr bool PERM = true, AFTER_DRAIN = false;
    bf16_t* O; int ldc; int coff; const bf16_t* Y; const float* bias;
    DEVI void apply8(int row, int col, f32x4 v0, f32x4 v1) const {
        if (ACT == 2) {
#pragma unroll
            for (int i = 0; i < 4; ++i) { float a = fmaxf(v0[i], 0.f), b = fmaxf(v1[i], 0.f); v0[i] = a * a; v1[i] = b * b; }
        }
        if (ACT == 3) {
            const u32x4 yw = *(const u32x4*)(Y + (size_t)row * 256 + col);
            const f32x4 b0 = *(const f32x4*)(bias + col), b1 = *(const f32x4*)(bias + col + 4);
#pragma unroll
            for (int i = 0; i < 4; ++i) {
                const unsigned w0 = yw[i >> 1], w1 = yw[2 + (i >> 1)];
                const float y0 = (i & 1) ? __uint_as_float(w0 & 0xffff0000u) : __uint_as_float(w0 << 16);
                const float y1 = (i & 1) ? __uint_as_float(w1 & 0xffff0000u) : __uint_as_float(w1 << 16);
                v0[i] = y0 * rcpf(1.f + __expf(-(v0[i] + b0[i])));
                v1[i] = y1 * rcpf(1.f + __expf(-(v1[i] + b1[i])));
            }
        }
        u32x4 w; w.x = pk2(v0[0], v0[1]); w.y = pk2(v0[2], v0[3]); w.z = pk2(v1[0], v1[1]); w.w = pk2(v1[2], v1[3]);
        *(u32x4*)(O + (size_t)row * ldc + coff + col) = w;
    }
    DEVI void operator()(const f32x4 (&acc)[2][2][4][2], const Unit& u, int wr, int wc, int fr, int fq) const {
        const int row0 = u.pm * 256 + wr * 64 + fr, col0 = u.pn * 256 + wc * 32 + 8 * fq;
#pragma unroll
        for (int ai = 0; ai < 2; ++ai)
#pragma unroll
            for (int m = 0; m < 4; ++m)
#pragma unroll
                for (int bj = 0; bj < 2; ++bj) { apply8(row0 + ai * 128 + m * 16, col0 + bj * 128, acc[ai][bj][m][0], acc[ai][bj][m][1]); if (ACT == 3) asm volatile("" ::: "memory"); }
    }
    DEVI void elem4(int row, int col, f32x4 v) const {
        if (ACT == 2) {
#pragma unroll
            for (int i = 0; i < 4; ++i) { float a = fmaxf(v[i], 0.f); v[i] = a * a; }
        }
        if (ACT == 3) {
            const u32x2 yw = *(const u32x2*)(Y + (size_t)row * 256 + col);
            const f32x4 b0 = *(const f32x4*)(bias + col);
#pragma unroll
            for (int i = 0; i < 4; ++i) {
                const unsigned w0 = yw[i >> 1];
                const float y0 = (i & 1) ? __uint_as_float(w0 & 0xffff0000u) : __uint_as_float(w0 << 16);
                v[i] = y0 * rcpf(1.f + __expf(-(v[i] + b0[i])));
            }
        }
        u32x2 w; w.x = pk2(v[0], v[1]); w.y = pk2(v[2], v[3]);
        *(u32x2*)(O + (size_t)row * ldc + coff + col) = w;
    }
};
struct EpiRes {
    static constexpr bool PERM = false, AFTER_DRAIN = false;
    const float* base; float* out; const float* sbase; float* sout;
    DEVI void operator()(const f32x4 (&acc)[2][2][4][2], const Unit& u, int wr, int wc, int fr, int fq) const {
        const int row0 = u.pm * 256 + wr * 64 + fr, col0 = u.pn * 256 + wc * 32 + 4 * fq;
#pragma unroll
        for (int ai = 0; ai < 2; ++ai)
#pragma unroll
            for (int m = 0; m < 4; ++m) {
                const size_t ro = (size_t)(row0 + ai * 128 + m * 16) * DM;
#pragma unroll
                for (int bj = 0; bj < 2; ++bj)
#pragma unroll
                    for (int n = 0; n < 2; ++n) {
                        const size_t o = ro + col0 + bj * 128 + n * 16;
                        const f32x4 b = *(const f32x4*)(base + o);
                        *(f32x4*)(out + o) = b * ALPHA + acc[ai][bj][m][n];
                    }
                asm volatile("" ::: "memory");
            }
    }
    DEVI void elem4(int row, int col, f32x4 v) const {
        const size_t o = (size_t)(row - NP) * DM + col;
        const f32x4 b = *(const f32x4*)(sbase + o);
        *(f32x4*)(sout + o) = b * ALPHA + v;
    }
};

template <class Epi> DEVI void sample_gemm(const bf16_t* A, const bf16_t* Bt, int N, int K, const Epi& E, int wave, int bx, int Gp) {
    const int lane = hw_lane();
    const int fr = lane & 15, fq = lane >> 4;
    const bf16_t* ap = A + (size_t)(NP + wave * 16 + fr) * K + fq * 8;
    for (int u = bx; u < N / 16; u += Gp) {
        const bf16_t* bp = Bt + (size_t)(u * 16 + fr) * K + fq * 8;
        f32x4 acc = {0.f, 0.f, 0.f, 0.f};
#pragma unroll 8
        for (int k = 0; k < K; k += 32) {
            const bf16x8 a = *(const bf16x8*)(ap + k), b = *(const bf16x8*)(bp + k);
            acc = __builtin_amdgcn_mfma_f32_16x16x32_bf16(b, a, acc, 0, 0, 0);
        }
        E.elem4(NP + wave * 16 + fr, u * 16 + fq * 4, acc);
    }
}

DEVI void transpose_item(const float* W, int K, int N, bf16_t* WT, LAS float* scr, int item, int lane) {
    const int nblk = N / 32, kb = item / nblk, nb = item % nblk, k0 = 64 * kb, n0 = 32 * nb;
#pragma unroll 8
    for (int i = 0; i < 32; ++i) { const int kk = 2 * i + (lane >> 5); scr[kk * 33 + (lane & 31)] = W[(size_t)(k0 + kk) * N + n0 + (lane & 31)]; }
    LDSW();
    const int c = lane & 7;
#pragma unroll
    for (int j = 0; j < 4; ++j) { const int n = (lane >> 3) + 8 * j; const LAS float* s = scr + (8 * c) * 33 + n;
        u32x4 o; o.x = pk2(s[0 * 33], s[1 * 33]); o.y = pk2(s[2 * 33], s[3 * 33]); o.z = pk2(s[4 * 33], s[5 * 33]); o.w = pk2(s[6 * 33], s[7 * 33]);
        *(u32x4*)(WT + (size_t)(n0 + n) * K + k0 + 8 * c) = o; }
    LDSW();
}
DEVI void sincos_rev(double ang, float& s, float& c) {
    const double rev = ang * 0.15915494309189535; const float fr = (float)(rev - rint(rev));
    s = __builtin_amdgcn_sinf(fr); c = __builtin_amdgcn_cosf(fr);
}
DEVI void prologue(const Args& a, LAS unsigned char* lds, int wave, int lane, int gw, int ngw) {
    lane = hw_lane();
    unsigned char* ws = a.ws;
    LAS float* scr = (LAS float*)(lds + wave * 16384);
    constexpr int I_IN = 16 * 92, I_OUT = 16 * 32, I_UP = 16 * 128, I_DN = 64 * 32, I_GL = 4 * 8, I_L = I_IN + I_OUT + I_UP + I_DN + I_GL;
    for (int it = gw; it < DEPTH * I_L; it += ngw) {
        const int l = it / I_L; int r = it % I_L;
        if (r < I_IN) { transpose_item(a.in[6] + (size_t)l * DM * INW, DM, INW, (bf16_t*)(ws + WS_WIN) + (size_t)l * INP * DM, scr, r, lane); continue; } r -= I_IN;
        if (r < I_OUT) { transpose_item(a.in[20] + (size_t)l * DM * DM, DM, DM, (bf16_t*)(ws + WS_WOUT) + (size_t)l * DM * DM, scr, r, lane); continue; } r -= I_OUT;
        if (r < I_UP) { transpose_item(a.in[23] + (size_t)l * DM * FF, DM, FF, (bf16_t*)(ws + WS_WUP) + (size_t)l * FF * DM, scr, r, lane); continue; } r -= I_UP;
        if (r < I_DN) { transpose_item(a.in[24] + (size_t)l * FF * DM, FF, DM, (bf16_t*)(ws + WS_WDN) + (size_t)l * DM * FF, scr, r, lane); continue; } r -= I_DN;
        transpose_item(a.in[18] + (size_t)l * 256 * 256, 256, 256, (bf16_t*)(ws + WS_WGLU) + (size_t)l * 256 * 256, scr, r, lane);
    }
    bf16_t* XB = (bf16_t*)(ws + WS_XB);
    for (int row = gw; row < MT; row += ngw) {
        const float* src = row < NP ? a.in[0] + (size_t)row * DM : a.in[1] + (size_t)(row - NP) * DM;
#pragma unroll
        for (int j = 0; j < 4; ++j) { const f32x4 v = *((const f32x4*)src + lane + 64 * j); u32x2 w; w.x = pk2(v[0], v[1]); w.y = pk2(v[2], v[3]);
            *((u32x2*)(XB + (size_t)row * DM) + lane + 64 * j) = w; }
    }
    const int gt = gw * 64 + lane, ngt = ngw * 64;
    f32x2* ROPE = (f32x2*)(ws + WS_ROPE);
    for (int i = gt; i < 2049 * 16; i += ngt) {
        const int p = i >> 4, f = i & 15; const float pos = p < 2048 ? (float)p : 16384.f;
        const float inv = exp2f(-(float)f * 0.83048202372184059f);
        float s, c; sincos_rev((double)pos * (double)inv, s, c);
        ROPE[i] = (f32x2){c, s};
    }
    float* LB = (float*)(ws + WS_LB);
    for (int i = gt; i < 384; i += ngt) {
        const float l0 = a.in[7][i], l1 = a.in[7][384 + i], l2 = a.in[7][768 + i], l3 = a.in[7][1152 + i];
        const float mx = fmaxf(fmaxf(l0, l1), fmaxf(l2, l3));
        const float e0 = expf(l0 - mx), e1 = expf(l1 - mx), e2 = expf(l2 - mx), e3 = expf(l3 - mx), inv = 1.f / (e0 + e1 + e2 + e3);
        LB[i] = 0.f; LB[384 + i] = e1 * inv; LB[768 + i] = (e1 + e2) * inv; LB[1152 + i] = (e1 + e2 + e3) * inv;
    }
    f32x2* APOW = (f32x2*)(ws + WS_APOW); f32x2* GT = (f32x2*)(ws + WS_GT); bf16_t* BB = (bf16_t*)(ws + WS_BB); bf16_t* CM = (bf16_t*)(ws + WS_CM);
    for (int i = gt; i < DEPTH * 16 * 64; i += ngt) {
        const int lg = i >> 6, n = i & 63;
        const float dt = expf(a.in[10][lg]); const float are = a.in[11][i], aim = a.in[12][i];
        float abr = 0.f, abi = 0.f;
        for (int m = 1; m <= 17; ++m) {
            const int mm = m <= 16 ? m : 64;
            const float mag = expf((float)mm * dt * are); float s, c; sincos_rev((double)mm * (double)dt * (double)aim, s, c);
            APOW[(size_t)(lg * 17 + (m - 1)) * 64 + n] = (f32x2){mag * c, mag * s};
            if (m == 1) { abr = mag * c; abi = mag * s; }
        }
        const float den = are * are + aim * aim, nr = abr - 1.f;
        const float gr = (nr * are + abi * aim) / den, gi = (abi * are - nr * aim) / den;
        GT[i] = (f32x2){gr, gi};
        const float* bre = a.in[13] + (size_t)i * 16; const float* bim = a.in[14] + (size_t)i * 16;
#pragma unroll
        for (int c2 = 0; c2 < 16; c2 += 2) {
            const float r0 = bre[c2], r1 = bre[c2 + 1], i0 = bim[c2], i1 = bim[c2 + 1];
            *(unsigned*)(BB + ((size_t)lg * 128 + n) * 16 + c2) = pk2(gr * r0 - gi * i0, gr * r1 - gi * i1);
            *(unsigned*)(BB + ((size_t)lg * 128 + 64 + n) * 16 + c2) = pk2(gr * i0 + gi * r0, gr * i1 + gi * r1);
        }
    }
    for (int i = gt; i < DEPTH * 16 * 16 * 128; i += ngt) {
        const int nn = i & 127, lgc = i >> 7;
        const float v = nn < 64 ? a.in[15][(size_t)lgc * 64 + nn] : -a.in[16][(size_t)lgc * 64 + nn - 64];
        CM[i] = f2bf1(v);
    }
}

DEVI void ln_phase(float* xf, const float* w, const float* b, bf16_t* xb, int lane, int gw, int ngw) {
    lane = hw_lane();
    for (int row = gw; row < MT; row += ngw) {
        f32x4* xr = (f32x4*)(xf + (size_t)row * DM) + lane;
        f32x4 v[4]; float s = 0.f;
#pragma unroll
        for (int j = 0; j < 4; ++j) { v[j] = xr[64 * j]; s += (v[j][0] + v[j][1]) + (v[j][2] + v[j][3]); }
        const float mean = wave_sum(s) * (1.f / DM); float s2 = 0.f;
#pragma unroll
        for (int j = 0; j < 4; ++j) { v[j] = v[j] - mean; s2 += (v[j][0] * v[j][0] + v[j][1] * v[j][1]) + (v[j][2] * v[j][2] + v[j][3] * v[j][3]); }
        const float rstd = 1.f / sqrtf(wave_sum(s2) * (1.f / DM) + LN_EPS);
#pragma unroll
        for (int j = 0; j < 4; ++j) {
            const f32x4 wv = *((const f32x4*)w + lane + 64 * j), bv = *((const f32x4*)b + lane + 64 * j);
            const f32x4 o = v[j] * rstd * wv + bv;
            xr[64 * j] = o;
            u32x2 pw; pw.x = pk2(o[0], o[1]); pw.y = pk2(o[2], o[3]);
            *((u32x2*)(xb + (size_t)row * DM) + lane + 64 * j) = pw;
        }
    }
}

template <int DK, bool HG, bool PC>
DEVI void la_unit(const Args& a, unsigned char* wsx, LAS unsigned char* wl, int lane, int layer, int h, const bf16_t* pr0, int pos0, float* sbuf, float* dbuf, bf16_t* mix0) {
    constexpr int NKT = DK / 16;
    constexpr int QOFF = HG ? C_HQ : C_RQ, KOFF = HG ? C_HF : C_RK, VOFF = HG ? C_HI : C_RV, GOFF = HG ? C_HGG : C_RG;
    const int fr = lane & 15, fq = lane >> 4;
    LAS bf16_t* QS = (LAS bf16_t*)wl; LAS bf16_t* KS = (LAS bf16_t*)(wl + 2304); LAS bf16_t* KT = (LAS bf16_t*)(wl + 4608);
    LAS bf16_t* VT = (LAS bf16_t*)(wl + 7680); LAS float* CD = (LAS float*)(wl + 10752);
    const unsigned char* ws = wsx;
    f32x4 S[NKT][4];
#pragma unroll
    for (int kt = 0; kt < NKT; ++kt)
#pragma unroll
        for (int vt = 0; vt < 4; ++vt)
#pragma unroll
            for (int j = 0; j < 4; ++j) S[kt][vt][j] = PC ? sbuf[(kt * 16 + fq * 4 + j) * 64 + vt * 16 + fr] : 0.f;
    float btot = 0.f;
    float lb = 0.f, oml = 1.f, lg = 0.f;
    if (HG) { lb = ((const float*)(ws + WS_LB))[layer * 384 + h * 64 + lane]; oml = 1.f - lb; }
    else { lg = log1pf(-exp2f(-5.f - (float)h)); }
    const f32x2* ROPE = (const f32x2*)(ws + WS_ROPE);
    float nw[4];
#pragma unroll
    for (int vt = 0; vt < 4; ++vt) nw[vt] = HG ? a.in[8][layer * 64 + vt * 16 + fr] : a.in[9][layer * 384 + h * 64 + vt * 16 + fr];

    for (int c = 0; c < 4; ++c) {
        const bf16_t* pr = pr0 + (size_t)c * 16 * INP;
        if (HG) {
            float b15 = 0.f;
#pragma unroll 4
            for (int t = 0; t < 16; ++t) {
                float z = bf2f(pr[t * INP + KOFF + h * 64 + lane]); z = fminf(fmaxf(z, -30.f), 30.f);
                b15 += __logf(lb + oml * rcpf(1.f + __expf(-z)));
            }
            float b = 0.f;
#pragma unroll 4
            for (int t = 0; t < 16; ++t) {
                float z = bf2f(pr[t * INP + KOFF + h * 64 + lane]); z = fminf(fmaxf(z, -30.f), 30.f);
                const float e = __expf(-z), sg = rcpf(1.f + e), f = lb + oml * sg;
                b += __logf(f);
                const float kv = oml * e * sg;
                if (PC) {
                    const float q = siluf(bf2f(pr[t * INP + QOFF + h * 64 + lane]));
                    QS[t * 72 + lane] = f2bf1(q * __expf(b));
                    KS[t * 72 + lane] = f2bf1(kv * __expf(fminf(-b, 80.f)));
                }
                KT[lane * 24 + t] = f2bf1(kv * __expf(b15 - b));
                VT[lane * 24 + t] = pr[t * INP + VOFF + h * 64 + lane];
            }
            CD[lane] = __expf(b15); btot += b15;
        } else {
#pragma unroll 4
            for (int t = 0; t < 16; ++t) VT[lane * 24 + t] = pr[t * INP + VOFF + h * 64 + lane];
            if (lane < 32) {
                const int i = lane & 15; const bool lo = lane < 16;
#pragma unroll 4
                for (int t = 0; t < 16; ++t) {
                    const f32x2 cs = ROPE[(pos0 + c * 16 + t) * 16 + i];
                    const float xk = bf2f(pr[t * INP + KOFF + h * 32 + lane]), xkp = bf2f(pr[t * INP + KOFF + h * 32 + (lane ^ 16)]);
                    const float k = (lo ? xk * cs[0] - xkp * cs[1] : xkp * cs[1] + xk * cs[0]) * 0.17677669529663687f;
                    KT[lane * 24 + t] = f2bf1(k * __expf((float)(15 - t) * lg));
                    if (PC) {
                        const float xq = bf2f(pr[t * INP + QOFF + h * 32 + lane]), xqp = bf2f(pr[t * INP + QOFF + h * 32 + (lane ^ 16)]);
                        const float q = lo ? xq * cs[0] - xqp * cs[1] : xqp * cs[1] + xq * cs[0];
                        QS[t * 72 + lane] = f2bf1(q * __expf((float)(t + 1) * lg));
                        KS[t * 72 + lane] = f2bf1(k * __expf(-(float)(t + 1) * lg));
                    }
                }
                CD[lane] = __expf(16.f * lg);
            }
        }
        LDSW();
        bf16x4 vf[4], ktf[NKT];
#pragma unroll
        for (int vt = 0; vt < 4; ++vt) vf[vt] = *(const LAS bf16x4*)(VT + (vt * 16 + fr) * 24 + fq * 4);
#pragma unroll
        for (int kt = 0; kt < NKT; ++kt) ktf[kt] = *(const LAS bf16x4*)(KT + (kt * 16 + fr) * 24 + fq * 4);
        f32x4 O[4];
        if (PC) {
            bf16x4 qf[NKT], kf[NKT];
#pragma unroll
            for (int kt = 0; kt < NKT; ++kt) { qf[kt] = *(const LAS bf16x4*)(QS + fr * 72 + kt * 16 + fq * 4); kf[kt] = *(const LAS bf16x4*)(KS + fr * 72 + kt * 16 + fq * 4); }
            f32x4 sc = {0.f, 0.f, 0.f, 0.f};
#pragma unroll
            for (int kt = 0; kt < NKT; ++kt) sc = MFMA16(kf[kt], qf[kt], sc);
#pragma unroll
            for (int j = 0; j < 4; ++j) if (fq * 4 + j > fr) sc[j] = 0.f;
            const bf16x4 pf = cvt4(sc);
#pragma unroll
            for (int vt = 0; vt < 4; ++vt) {
                f32x4 o = {0.f, 0.f, 0.f, 0.f};
#pragma unroll
                for (int kt = 0; kt < NKT; ++kt) o = MFMA16(qf[kt], cvt4(S[kt][vt]), o);
                O[vt] = MFMA16(pf, vf[vt], o);
            }
        }
#pragma unroll
        for (int kt = 0; kt < NKT; ++kt) {
            const f32x4 cd4 = *(const LAS f32x4*)(CD + kt * 16 + fq * 4);
#pragma unroll
            for (int vt = 0; vt < 4; ++vt) S[kt][vt] = MFMA16(ktf[kt], vf[vt], S[kt][vt] * cd4);
        }
        if (PC) {
            float rs[4], mu[4];
#pragma unroll
            for (int j = 0; j < 4; ++j) {
                if (HG) {
                    float ss = (O[0][j] * O[0][j] + O[1][j] * O[1][j]) + (O[2][j] * O[2][j] + O[3][j] * O[3][j]);
                    ss = row16_sum(ss); mu[j] = 0.f; rs[j] = rsqrtf(ss * (1.f / 64.f) + LN_EPS);
                } else {
                    float sm = (O[0][j] + O[1][j]) + (O[2][j] + O[3][j]); sm = row16_sum(sm); mu[j] = sm * (1.f / 64.f);
                    const float d0 = O[0][j] - mu[j], d1 = O[1][j] - mu[j], d2 = O[2][j] - mu[j], d3 = O[3][j] - mu[j];
                    float ss = (d0 * d0 + d1 * d1) + (d2 * d2 + d3 * d3); ss = row16_sum(ss); rs[j] = rsqrtf(ss * (1.f / 64.f) + LN_EPS);
                }
            }
#pragma unroll
            for (int vt = 0; vt < 4; ++vt)
#pragma unroll
                for (int j = 0; j < 4; ++j) {
                    const int t = fq * 4 + j, v = vt * 16 + fr;
                    const float gte = siluf(bf2f(pr[t * INP + GOFF + h * 64 + v]));
                    mix0[(size_t)(c * 16 + t) * DM + (HG ? 0 : 384) + h * 64 + v] = f2bf1((O[vt][j] - mu[j]) * rs[j] * nw[vt] * gte);
                }
        }
        LDSW();
    }
    if (!PC) {
#pragma unroll
        for (int kt = 0; kt < NKT; ++kt)
#pragma unroll
            for (int vt = 0; vt < 4; ++vt)
#pragma unroll
                for (int j = 0; j < 4; ++j) sbuf[(kt * 16 + fq * 4 + j) * 64 + vt * 16 + fr] = S[kt][vt][j];
        if (HG) dbuf[lane] = __expf(btot);
    }
}

template <bool PC>
DEVI void s5_unit(const Args& a, unsigned char* wsx, int lane, int layer, int g, const bf16_t* pr0, float* xbuf, bf16_t* y50) {
    const int fr = lane & 15, fq = lane >> 4, lgi = layer * 16 + g;
    const unsigned char* ws = wsx;
    const bf16_t* BB = (const bf16_t*)(ws + WS_BB) + (size_t)lgi * 128 * 16;
    const bf16_t* CM = (const bf16_t*)(ws + WS_CM) + (size_t)lgi * 16 * 128;
    const f32x2* APOW = (const f32x2*)(ws + WS_APOW) + (size_t)lgi * 17 * 64;
    bf16x4 bbf[8], cmf[8];
#pragma unroll
    for (int r = 0; r < 8; ++r) bbf[r] = *(const bf16x4*)(BB + (r * 16 + fr) * 16 + fq * 4);
    if (PC) {
#pragma unroll
        for (int s = 0; s < 8; ++s) cmf[s] = *(const bf16x4*)(CM + fr * 128 + s * 16 + fq * 4);
    }
    float xnr[4][4], xni[4][4];
#pragma unroll
    for (int r = 0; r < 4; ++r)
#pragma unroll
        for (int j = 0; j < 4; ++j) {
            const int n = r * 16 + fq * 4 + j;
            xnr[r][j] = PC ? xbuf[n] : 0.f; xni[r][j] = PC ? xbuf[64 + n] : 0.f;
        }
    f32x4 dd = {0.f, 0.f, 0.f, 0.f};
    if (PC) dd = *(const f32x4*)(a.in[17] + layer * 256 + g * 16 + fq * 4);
    for (int c = 0; c < 4; ++c) {
        const bf16x4 uf = *(const bf16x4*)(pr0 + (size_t)(c * 16 + fr) * INP + C_SU + g * 16 + fq * 4);
        const f32x4 z4 = {0.f, 0.f, 0.f, 0.f};
        f32x4 xr[4], xi[4];
#pragma unroll
        for (int r = 0; r < 4; ++r) { xr[r] = MFMA16(bbf[r], uf, z4); xi[r] = MFMA16(bbf[r + 4], uf, z4); }
        int noff = fq * 4; asm volatile("" : "+v"(noff));
        f32x2 m[4][4];
#pragma unroll
        for (int r = 0; r < 4; ++r) { const f32x4 t0 = *(const f32x4*)(APOW + r * 16 + noff), t1 = *(const f32x4*)(APOW + r * 16 + noff + 2);
            m[r][0] = (f32x2){t0[0], t0[1]}; m[r][1] = (f32x2){t0[2], t0[3]}; m[r][2] = (f32x2){t1[0], t1[1]}; m[r][3] = (f32x2){t1[2], t1[3]}; }
#define S5_STEP(D) do { _Pragma("unroll") for (int r = 0; r < 4; ++r) _Pragma("unroll") for (int j = 0; j < 4; ++j) { \
            const float pr_ = dpp_shr<D>(xr[r][j]), pi_ = dpp_shr<D>(xi[r][j]); \
            xr[r][j] += m[r][j][0] * pr_ - m[r][j][1] * pi_; xi[r][j] += m[r][j][0] * pi_ + m[r][j][1] * pr_; } } while (0)
#define S5_SQ() do { _Pragma("unroll") for (int r = 0; r < 4; ++r) _Pragma("unroll") for (int j = 0; j < 4; ++j) { \
            const float mr = m[r][j][0], mi = m[r][j][1]; m[r][j][0] = mr * mr - mi * mi; m[r][j][1] = 2.f * mr * mi; } } while (0)
        S5_STEP(1); S5_SQ(); S5_STEP(2); S5_SQ(); S5_STEP(4); S5_SQ(); S5_STEP(8);
#undef S5_STEP
#undef S5_SQ
#pragma unroll
        for (int r = 0; r < 4; ++r) {
            const f32x4 t0 = *(const f32x4*)(APOW + fr * 64 + r * 16 + noff), t1 = *(const f32x4*)(APOW + fr * 64 + r * 16 + noff + 2);
            const float pwr[4] = {t0[0], t0[2], t1[0], t1[2]}, pwi[4] = {t0[1], t0[3], t1[1], t1[3]};
#pragma unroll
            for (int j = 0; j < 4; ++j) {
                xr[r][j] += pwr[j] * xnr[r][j] - pwi[j] * xni[r][j];
                xi[r][j] += pwr[j] * xni[r][j] + pwi[j] * xnr[r][j];
            }
        }
#pragma unroll
        for (int r = 0; r < 4; ++r)
#pragma unroll
            for (int j = 0; j < 4; ++j) { xnr[r][j] = bperm(xr[r][j], (lane & 48) | 15); xni[r][j] = bperm(xi[r][j], (lane & 48) | 15); }
        if (PC) {
            f32x4 y = {0.f, 0.f, 0.f, 0.f};
#pragma unroll
            for (int s = 0; s < 4; ++s) { y = MFMA16(cmf[s], cvt4(xr[s]), y); y = MFMA16(cmf[s + 4], cvt4(xi[s]), y); }
            f32x4 o;
#pragma unroll
            for (int j = 0; j < 4; ++j) {
                const float x = y[j] + dd[j] * bf2f((bf16_t)uf[j]);
                o[j] = x * rcpf(1.f + __expf(-1.5957691216057308f * (x + 0.044715f * x * x * x)));
            }
            *(bf16x4*)(y50 + (size_t)(c * 16 + fr) * 256 + g * 16 + fq * 4) = cvt4(o);
        }
    }
    if (!PC && fr == 15) {
#pragma unroll
        for (int r = 0; r < 4; ++r)
#pragma unroll
            for (int j = 0; j < 4; ++j) { const int n = r * 16 + fq * 4 + j; xbuf[n] = xnr[r][j]; xbuf[64 + n] = xni[r][j]; }
    }
}

template <bool PC>
DEVI void mixer_pass(const Args& a, unsigned char* wsx, LAS unsigned char* lds, int wave, int lane, int gw, int ngw, int layer) {
    lane = hw_lane();
    unsigned char* ws = wsx;
    const bf16_t* PROJ = (const bf16_t*)(ws + WS_PROJ); bf16_t* MIX = (bf16_t*)(ws + WS_MIX); bf16_t* Y5 = (bf16_t*)(ws + WS_Y5);
    LAS unsigned char* wl = lds + wave * 16384;
#ifndef NO_HG
    for (int u = gw; u < NU_HG; u += ngw) {
        const int seg = u & 31, bh = u >> 5, b = bh / 6, h = bh % 6; const size_t row = (size_t)b * SEQ + seg * SEGL;
        la_unit<64, true, PC>(a, ws, wl, lane, layer, h, PROJ + row * INP, seg * SEGL, (float*)(ws + WS_SHG) + (size_t)u * 4096, (float*)(ws + WS_DHG) + (size_t)u * 64, MIX + row * DM);
    }
#endif
    asm volatile("" : "+v"(lane));
#ifndef NO_RT
    for (int u = gw >= NU_HG ? gw : gw + ((NU_HG - gw + ngw - 1) / ngw) * ngw; u < NU_HG + NU_RT; u += ngw) {
        const int v = u - NU_HG, seg = v & 31, bh = v >> 5, b = bh / 6, h = bh % 6; const size_t row = (size_t)b * SEQ + seg * SEGL;
        la_unit<32, false, PC>(a, ws, wl, lane, layer, h, PROJ + row * INP, seg * SEGL, (float*)(ws + WS_SRT) + (size_t)v * 2048, nullptr, MIX + row * DM);
    }
#endif
    asm volatile("" : "+v"(lane));
#ifndef NO_S5
    for (int u = gw >= NU_HG + NU_RT ? gw : gw + ((NU_HG + NU_RT - gw + ngw - 1) / ngw) * ngw; u < NU_HG + NU_RT + NU_S5; u += ngw) {
        const int v = u - NU_HG - NU_RT, seg = v & 31, bg = v >> 5, b = bg >> 4, g = bg & 15; const size_t row = (size_t)b * SEQ + seg * SEGL;
        s5_unit<PC>(a, ws, lane, layer, g, PROJ + row * INP, (float*)(ws + WS_XS5) + (size_t)v * 128, Y5 + row * 256);
    }
#endif
}

DEVI void mixer_pass_b(const Args& a, unsigned char* wsx, int wave, int lane, int gw, int ngw, int layer) {
    lane = hw_lane();
    unsigned char* ws = wsx;
    const int gt = gw * 64 + lane, ngt = ngw * 64;
    float* SHG = (float*)(ws + WS_SHG); const float* DHG = (const float*)(ws + WS_DHG); float* SRT = (float*)(ws + WS_SRT); float* XS5 = (float*)(ws + WS_XS5);
    const f32x2* APOW = (const f32x2*)(ws + WS_APOW);
    for (int i = gt; i < 48 * 4096; i += ngt) {
        const int bh = i >> 12, e = i & 4095, k = e >> 6; float run = 0.f;
#pragma unroll 8
        for (int s = 0; s < NSEG; ++s) { const size_t u = (size_t)bh * NSEG + s; const float sl = SHG[u * 4096 + e], d = DHG[u * 64 + k]; SHG[u * 4096 + e] = run; run = d * run + sl; }
        a.out[O_HGP + ((size_t)layer * 48 + bh) * 4096 + e] = run;
    }
    for (int i = gt; i < 48 * 2048; i += ngt) {
        const int bh = i >> 11, e = i & 2047, h = bh % 6; float run = 0.f;
        const float d = __expf(64.f * log1pf(-exp2f(-5.f - (float)h)));
#pragma unroll 8
        for (int s = 0; s < NSEG; ++s) { const size_t u = (size_t)bh * NSEG + s; const float sl = SRT[u * 2048 + e]; SRT[u * 2048 + e] = run; run = d * run + sl; }
        a.out[O_RTP + ((size_t)layer * 48 + bh) * 2048 + e] = run;
    }
    for (int i = gt; i < 128 * 64; i += ngt) {
        const int bg = i >> 6, n = i & 63, g = bg & 15; const f32x2 a64 = APOW[(size_t)((layer * 16 + g) * 17 + 16) * 64 + n];
        float rr = 0.f, ri = 0.f;
#pragma unroll 8
        for (int s = 0; s < NSEG; ++s) { float* p = XS5 + ((size_t)bg * NSEG + s) * 128; const float lr = p[n], li = p[64 + n]; p[n] = rr; p[64 + n] = ri;
            const float nr = a64[0] * rr - a64[1] * ri + lr, ni = a64[0] * ri + a64[1] * rr + li; rr = nr; ri = ni; }
        a.out[O_S5RP + ((size_t)layer * 128 + bg) * 64 + n] = rr; a.out[O_S5IP + ((size_t)layer * 128 + bg) * 64 + n] = ri;
    }
    const bf16_t* PROJ = (const bf16_t*)(ws + WS_PROJ); bf16_t* MIX = (bf16_t*)(ws + WS_MIX); bf16_t* Y5 = (bf16_t*)(ws + WS_Y5);
    const f32x2* ROPE = (const f32x2*)(ws + WS_ROPE);
    for (int u = gw; u < 768 + 768 + 2048; u += ngw) {
        if (u < 768) {
            const int b = u / 6, h = u % 6; const bf16_t* pr = PROJ + (size_t)(NP + b) * INP;
            const float lb = ((const float*)(ws + WS_LB))[layer * 384 + h * 64 + lane], oml = 1.f - lb;
            float z = bf2f(pr[C_HF + h * 64 + lane]); z = fminf(fmaxf(z, -30.f), 30.f);
            const float e = __expf(-z), sg = rcpf(1.f + e), fk = lb + oml * sg, kk = oml * e * sg, qk = siluf(bf2f(pr[C_HQ + h * 64 + lane]));
            const float vv = bf2f(pr[C_HI + h * 64 + lane]);
            const float* s0 = a.in[2] + (((size_t)layer * 128 + b) * 6 + h) * 4096; float* s1 = a.out + O_HGS + (((size_t)layer * 128 + b) * 6 + h) * 4096;
            float o = 0.f;
#pragma unroll 8
            for (int k = 0; k < 64; ++k) { const float f = rdlane(fk, k), kv = rdlane(kk, k), q = rdlane(qk, k); const float s = f * s0[k * 64 + lane] + kv * vv; s1[k * 64 + lane] = s; o += q * s; }
            const float ss = wave_sum(o * o) * (1.f / 64.f);
            const float gte = siluf(bf2f(pr[C_HGG + h * 64 + lane]));
            MIX[(size_t)(NP + b) * DM + h * 64 + lane] = f2bf1(o * rsqrtf(ss + LN_EPS) * a.in[8][layer * 64 + lane] * gte);
        } else if (u < 1536) {
            const int v_ = u - 768, b = v_ / 6, h = v_ % 6; const bf16_t* pr = PROJ + (size_t)(NP + b) * INP;
            const float gam = 1.f - exp2f(-5.f - (float)h);
            const int kl = lane & 31, i = kl & 15; const bool lo = kl < 16; const f32x2 cs = ROPE[2048 * 16 + i];
            const float xk = bf2f(pr[C_RK + h * 32 + kl]), xkp = bf2f(pr[C_RK + h * 32 + (kl ^ 16)]);
            const float xq = bf2f(pr[C_RQ + h * 32 + kl]), xqp = bf2f(pr[C_RQ + h * 32 + (kl ^ 16)]);
            const float kk = (lo ? xk * cs[0] - xkp * cs[1] : xkp * cs[1] + xk * cs[0]) * 0.17677669529663687f;
            const float qk = lo ? xq * cs[0] - xqp * cs[1] : xqp * cs[1] + xq * cs[0];
            const float vv = bf2f(pr[C_RV + h * 64 + lane]);
            const float* s0 = a.in[3] + (((size_t)layer * 128 + b) * 6 + h) * 2048; float* s1 = a.out + O_RTS + (((size_t)layer * 128 + b) * 6 + h) * 2048;
            float o = 0.f;
#pragma unroll 8
            for (int k = 0; k < 32; ++k) { const float kv = rdlane(kk, k), q = rdlane(qk, k); const float s = gam * s0[k * 64 + lane] + kv * vv; s1[k * 64 + lane] = s; o += q * s; }
            const float mu = wave_sum(o) * (1.f / 64.f), d = o - mu, var = wave_sum(d * d) * (1.f / 64.f);
            const float gte = siluf(bf2f(pr[C_RG + h * 64 + lane]));
            MIX[(size_t)(NP + b) * DM + 384 + h * 64 + lane] = f2bf1(d * rsqrtf(var + LN_EPS) * a.in[9][layer * 384 + h * 64 + lane] * gte);
        } else {
            const int v_ = u - 1536, b = v_ >> 4, g = v_ & 15, lgi = layer * 16 + g; const bf16_t* pr = PROJ + (size_t)(NP + b) * INP;
            const f32x2 gt_ = ((const f32x2*)(ws + WS_GT))[lgi * 64 + lane], ab = APOW[(size_t)(lgi * 17) * 64 + lane];
            const float* bre = a.in[13] + ((size_t)lgi * 64 + lane) * 16; const float* bim = a.in[14] + ((size_t)lgi * 64 + lane) * 16;
            float uu[16], bur = 0.f, bui = 0.f;
#pragma unroll
            for (int c = 0; c < 16; ++c) { uu[c] = bf2f(pr[C_SU + g * 16 + c]); const float br = bre[c], bi = bim[c]; bur += (gt_[0] * br - gt_[1] * bi) * uu[c]; bui += (gt_[0] * bi + gt_[1] * br) * uu[c]; }
            const size_t so = (((size_t)layer * 128 + b) * 16 + g) * 64 + lane;
            const float x0r = a.in[4][so], x0i = a.in[5][so];
            const float x1r = ab[0] * x0r - ab[1] * x0i + bur, x1i = ab[0] * x0i + ab[1] * x0r + bui;
            a.out[O_S5RS + so] = x1r; a.out[O_S5IS + so] = x1i;
            float ymine = 0.f;
#pragma unroll
            for (int c = 0; c < 16; ++c) {
                const float cr = a.in[15][((size_t)lgi * 16 + c) * 64 + lane], ci = a.in[16][((size_t)lgi * 16 + c) * 64 + lane];
                const float y = wave_sum(cr * x1r - ci * x1i) + a.in[17][layer * 256 + g * 16 + c] * uu[c];
                if (lane == c) ymine = y;
            }
            if (lane < 16) { const float x = ymine; Y5[(size_t)(NP + b) * 256 + g * 16 + lane] = f2bf1(x * rcpf(1.f + __expf(-1.5957691216057308f * (x + 0.044715f * x * x * x)))); }
        }
    }
}

__global__ void __launch_bounds__(512, 2) fwd_megakernel(Args args) {
    extern __shared__ __attribute__((aligned(16))) unsigned char lds_raw[];
    cg::grid_group grid = cg::this_grid();
    LAS unsigned char* lds = (LAS unsigned char*)lds_raw;
    const int wave = __builtin_amdgcn_readfirstlane((int)threadIdx.x >> 6); const int lane = 0;
    const int G = gridDim.x, gw = blockIdx.x * 8 + wave, ngw = G * 8;
    unsigned char* const ws0 = args.ws;

#ifndef NO_PRO
    prologue(args, lds, wave, lane, gw, ngw);
#endif
    grid.sync();

    for (int l = 0; l < DEPTH; ++l) {
#define LP() int lp = l; asm volatile("" : "+s"(lp)); int wv = wave; asm volatile("" : "+s"(wv)); int bx = blockIdx.x; asm volatile("" : "+s"(bx)); int Gp = G; asm volatile("" : "+s"(Gp)); unsigned char* ws = ws0; asm volatile("" : "+s"(ws)); \
    bf16_t* XB = (bf16_t*)(ws + WS_XB); bf16_t* PROJ = (bf16_t*)(ws + WS_PROJ); bf16_t* MIX = (bf16_t*)(ws + WS_MIX); bf16_t* HID = (bf16_t*)(ws + WS_HID); bf16_t* Y5 = (bf16_t*)(ws + WS_Y5); (void)XB; (void)PROJ; (void)MIX; (void)HID; (void)Y5
        {
            LP(); const bf16_t* WIN = (const bf16_t*)(ws + WS_WIN) + (size_t)lp * INP * DM;
            pg8::Gemm g{XB, WIN, NP, INP, DM}; pg8::StaticOrder S; S.init(NP, INP, Gp, bx);
            EpiBf<0> E{PROJ, INP, 0, nullptr, nullptr};
#ifndef NO_GEMM
            pg8::gemm_phase<EpiBf<0>, pg8::StaticOrder, true, true>(lds, g, S, E, wv);
#endif
#ifndef NO_SG
            sample_gemm(XB, WIN, INW, DM, E, wv, bx, Gp);
#endif
        }
        grid.sync();
        { LP(); mixer_pass<false>(args, ws, lds, wv, lane, bx * 8 + wv, Gp * 8, lp); }
        grid.sync();

#ifndef NO_PB
        { LP(); mixer_pass_b(args, ws, wv, lane, bx * 8 + wv, Gp * 8, lp); }
#endif

        grid.sync();
        { LP(); mixer_pass<true>(args, ws, lds, wv, lane, bx * 8 + wv, Gp * 8, lp); }
        grid.sync();
        {
            LP(); const bf16_t* WGLU = (const bf16_t*)(ws + WS_WGLU) + (size_t)lp * 256 * 256;
            pg8::Gemm g{Y5, WGLU, NP, 256, 256}; pg8::StaticOrder S; S.init(NP, 256, Gp, bx);
            EpiBf<3> E{MIX, DM, 768, Y5, args.in[19] + lp * 256};
#ifndef NO_GEMM
            pg8::gemm_phase<EpiBf<3>, pg8::StaticOrder, true, true>(lds, g, S, E, wv);
#endif
#ifndef NO_SG
            sample_gemm(Y5, WGLU, 256, 256, E, wv, bx, Gp);
#endif
        }
        grid.sync();
        {
            LP(); const bf16_t* WOUT = (const bf16_t*)(ws + WS_WOUT) + (size_t)lp * DM * DM;
            pg8::Gemm g{MIX, WOUT, NP, DM, DM}; pg8::StaticOrder S; S.init(NP, DM, Gp, bx);
            EpiRes E{lp == 0 ? args.in[0] : args.out, args.out, lp == 0 ? args.in[1] : args.out + O_YS, args.out + O_YS};
#ifndef NO_GEMM
            pg8::gemm_phase<EpiRes, pg8::StaticOrder, true, true>(lds, g, S, E, wv);
#endif
#ifndef NO_SG
            sample_gemm(MIX, WOUT, DM, DM, E, wv, bx, Gp);
#endif
        }
        grid.sync();
        { LP(); ln_phase(args.out, args.in[21] + lp * DM, args.in[22] + lp * DM, XB, lane, bx * 8 + wv, Gp * 8); }
        grid.sync();
        {
            LP(); const bf16_t* WUP = (const bf16_t*)(ws + WS_WUP) + (size_t)lp * FF * DM;
            pg8::Gemm g{XB, WUP, NP, FF, DM}; pg8::StaticOrder S; S.init(NP, FF, Gp, bx);
            EpiBf<2> E{HID, FF, 0, nullptr, nullptr};
#ifndef NO_GEMM
            pg8::gemm_phase<EpiBf<2>, pg8::StaticOrder, true, true>(lds, g, S, E, wv);
#endif
#ifndef NO_SG
            sample_gemm(XB, WUP, FF, DM, E, wv, bx, Gp);
#endif
        }
        grid.sync();
        {
            LP(); const bf16_t* WDN = (const bf16_t*)(ws + WS_WDN) + (size_t)lp * DM * FF;
            pg8::Gemm g{HID, WDN, NP, DM, FF}; pg8::StaticOrder S; S.init(NP, DM, Gp, bx);
            EpiRes E{args.out, args.out, args.out + O_YS, args.out + O_YS};
#ifndef NO_GEMM
            pg8::gemm_phase<EpiRes, pg8::StaticOrder, true, true>(lds, g, S, E, wv);
#endif
#ifndef NO_SG
            sample_gemm(HID, WDN, DM, FF, E, wv, bx, Gp);
#endif
        }
        grid.sync();
        { LP(); ln_phase(args.out, args.in[25] + lp * DM, args.in[26] + lp * DM, XB, lane, bx * 8 + wv, Gp * 8); }
        if (l + 1 < DEPTH) grid.sync();
#undef LP
    }
}

extern "C" void kernel_launch(void* const* d_in, const int* in_sizes, int n_in, void* d_out, int out_size, void* d_ws, size_t ws_size, hipStream_t stream) {
    static int grid = 0;
    if (grid == 0) {
        int dev = 0, cus = 0, per_cu = 0;
        hipGetDevice(&dev);
        hipDeviceGetAttribute(&cus, hipDeviceAttributeMultiprocessorCount, dev);
        hipFuncSetAttribute((const void*)fwd_megakernel, hipFuncAttributeMaxDynamicSharedMemorySize, LDS_BYTES);
        hipOccupancyMaxActiveBlocksPerMultiprocessor(&per_cu, (const void*)fwd_megakernel, 512, LDS_BYTES);
        if (per_cu < 1) { fprintf(stderr, "kernel_launch: occupancy query says %d blocks per CU\n", per_cu); per_cu = 1; }
        (void)hipGetLastError();
        grid = cus;
        if (n_in != 27 || ws_size < WS_END) fprintf(stderr, "kernel_launch: unexpected n_in %d / ws_size %zu\n", n_in, ws_size);
    }
    Args a{};
    for (int i = 0; i < 27; ++i) a.in[i] = (const float*)d_in[i];
    a.out = (float*)d_out; a.ws = (unsigned char*)d_ws;
    void* kargs[] = {&a};
    hipError_t e = hipLaunchCooperativeKernel((const void*)fwd_megakernel, dim3(grid), dim3(512), kargs, LDS_BYTES, stream);
    if (e != hipSuccess) fprintf(stderr, "cooperative launch failed: %s (grid %d)\n", hipGetErrorString(e), grid);
}
```

```cpp
#include <hip/hip_runtime.h>
#include <hip/hip_cooperative_groups.h>
#include <cstdio>
#include <cstdint>
namespace cg = cooperative_groups;
namespace pg8 {
#define PG8_LAS __attribute__((address_space(3)))
typedef unsigned short bf16_t;
typedef short bf16x8 __attribute__((ext_vector_type(8)));
typedef float f32x4 __attribute__((ext_vector_type(4)));
typedef unsigned u32x4 __attribute__((ext_vector_type(4)));
constexpr int BM = 256, BK = 64, HALF = 128, HTB = HALF * BK * 2  , STAGE_BYTES = 8 * HTB, NXCD = 8, WGM = 8;

__host__ __device__ __forceinline__ int lds_byte(int r, int c) { const int st = (r >> 4) * 2 + (c >> 5), rr = r & 15, cc = c & 31, ob = rr * 64 + cc * 2; return st * 1024 + (ob ^ (((ob >> 9) & 1) << 5)); }
__host__ __device__ __forceinline__ void stage_rc(int b, int& R, int& C) { const int st = b / 1024, sb = b % 1024, swz = sb ^ (((sb >> 9) & 1) << 5); R = (st >> 1) * 16 + swz / 64; C = (st & 1) * 32 + (swz % 64) / 2; }
__host__ __device__ __forceinline__ int perm32(int rho) { const int n = rho >> 4, i = rho & 15; return 8 * (i >> 2) + 4 * n + (i & 3); }

struct Unit { int pm, pn; };
struct Gemm { const bf16_t* A; const bf16_t* Bt; int M, N, K; };

struct StaticOrder {
    int nM, nN, nwg, G, c;
    __host__ __device__ void init(int M, int N, int G_, int c_) { nM = M / BM; nN = N / BM; nwg = nM * nN; G = G_; c = c_; }
    __host__ __device__ bool next(int i, Unit& u) const {
        const long L = (long)i * G + c; if (L >= nwg) return false;
        int wgid = (int)L; { const int q = nwg / NXCD, r = nwg % NXCD, xcd = wgid % NXCD, off = wgid / NXCD; wgid = (xcd < r ? xcd * (q + 1) : r * (q + 1) + (xcd - r) * q) + off; }
        const int nig = WGM * nN, gid = wgid / nig, fm = gid * WGM, gsz = (nM - fm) < WGM ? (nM - fm) : WGM;
        u.pm = fm + ((wgid % nig) % gsz); u.pn = (wgid % nig) / gsz; return true;
    }
    __device__ __forceinline__ void a_ready(const Unit&) const {}
    __device__ __forceinline__ void done(const Unit&) const {}
};
template <class Epi, class Sched, bool ALIGN_EPI = false, bool SP2 = false>
__device__ __forceinline__ void gemm_phase(PG8_LAS unsigned char* lds, const Gemm g, const Sched& S, const Epi& E, const int wid) {
    int lane_; asm volatile("v_mbcnt_lo_u32_b32 %0, -1, 0\n\tv_mbcnt_hi_u32_b32 %0, -1, %0" : "=v"(lane_));
    const int lane = lane_, tid = wid * 64 + lane, wr = wid >> 2, wc = wid & 3, fr = lane & 15, fq = lane >> 4;
    const int K = g.K, nt = K / BK;
    unsigned voffA[2], voffB[2];
#pragma unroll
    for (int i = 0; i < 2; ++i) { int R, C; stage_rc(tid * 16 + i * 8192, R, C); const int Rb = Epi::PERM ? ((R & ~31) + perm32(R & 31)) : R;
        voffA[i] = (unsigned)(R * K + C) * 2u; voffB[i] = (unsigned)(Rb * K + C) * 2u; }
    const size_t kstep = (size_t)(BK * 2);
    const size_t hstep = (size_t)HALF * K * 2;
    const size_t tstep = 2 * hstep;
    const unsigned ldsw = (unsigned)wid * 1024u;
    const int aoff = lds_byte(wr * 64 + fr, fq * 8), boff = lds_byte(wc * 32 + fr, fq * 8);
#define PG8_SA(b, h) (((b) * 2 + (h)) * HTB)
#define PG8_SB(b, h) ((4 + (b) * 2 + (h)) * HTB)
#define PG8_STAGE(bufoff, gbase, voff) do { _Pragma("unroll") for (int _i = 0; _i < 2; ++_i) \
        __builtin_amdgcn_global_load_lds((const unsigned*)((const char*)(gbase) + (voff)[_i]), (PG8_LAS unsigned*)(lds + (bufoff) + ldsw + _i * 8192), 16, 0, 0); } while (0)
#define PG8_LDA(dst, b, h) do { _Pragma("unroll") for (int m = 0; m < 4; ++m) _Pragma("unroll") for (int k = 0; k < 2; ++k) dst[m][k] = *(const PG8_LAS bf16x8*)(lds + PG8_SA(b, h) + aoff + m * 2048 + k * 1024); } while (0)
#define PG8_LDB(dst, b, h) do { _Pragma("unroll") for (int n = 0; n < 2; ++n) _Pragma("unroll") for (int k = 0; k < 2; ++k) dst[n][k] = *(const PG8_LAS bf16x8*)(lds + PG8_SB(b, h) + boff + n * 2048 + k * 1024); } while (0)
#define PG8_MMA(ai, bj, At, Bt) do { __builtin_amdgcn_s_setprio(1); _Pragma("unroll") for (int m = 0; m < 4; ++m) _Pragma("unroll") for (int n = 0; n < 2; ++n) _Pragma("unroll") for (int k = 0; k < 2; ++k) \
        acc[ai][bj][m][n] = __builtin_amdgcn_mfma_f32_16x16x32_bf16(Bt[n][k], At[m][k], acc[ai][bj][m][n], 0, 0, 0); __builtin_amdgcn_s_setprio(0); } while (0)
#define PG8_WAIT_V(n) asm volatile("s_waitcnt vmcnt(" #n ")" ::: "memory")
#define PG8_WAIT_L(n) asm volatile("s_waitcnt lgkmcnt(" #n ")" ::: "memory")
#define PG8_BAR __builtin_amdgcn_s_barrier()
#define PG8_SCHED __builtin_amdgcn_sched_barrier(0)
    Unit cur, nxt; int ui = 0;
    if (!S.next(0, cur)) return;
    f32x4 acc[2][2][4][2];
#pragma unroll
    for (int a = 0; a < 2; ++a)
#pragma unroll
        for (int b = 0; b < 2; ++b)
#pragma unroll
            for (int m = 0; m < 4; ++m)
#pragma unroll
                for (int n = 0; n < 2; ++n) acc[a][b][m][n] = (f32x4){0.f, 0.f, 0.f, 0.f};
    bf16x8 At[4][2], B0[2][2], B1[2][2];
    const char* cA = (const char*)g.A + (size_t)cur.pm * tstep; const char* cB = (const char*)g.Bt + (size_t)cur.pn * tstep;
    S.a_ready(cur);
    if constexpr (SP2) {
        PG8_STAGE(PG8_SB(0, 0), cB, voffB); PG8_STAGE(PG8_SB(0, 1), cB + hstep, voffB); PG8_STAGE(PG8_SA(0, 0), cA, voffA); PG8_STAGE(PG8_SA(0, 1), cA + hstep, voffA);
        if (wr == 1) PG8_BAR;
        PG8_WAIT_V(2); PG8_BAR;
        PG8_STAGE(PG8_SB(1, 0), cB + kstep, voffB); PG8_STAGE(PG8_SA(1, 0), cA + kstep, voffA); PG8_STAGE(PG8_SB(1, 1), cB + hstep + kstep, voffB);
        PG8_WAIT_V(6); PG8_BAR;
    } else {
        PG8_STAGE(PG8_SB(0, 0), cB, voffB); PG8_STAGE(PG8_SA(0, 0), cA, voffA); PG8_STAGE(PG8_SB(0, 1), cB + hstep, voffB); PG8_STAGE(PG8_SA(0, 1), cA + hstep, voffA);
        if (wr == 1) PG8_BAR;
        PG8_WAIT_V(4); PG8_BAR;
        PG8_STAGE(PG8_SB(1, 0), cB + kstep, voffB); PG8_STAGE(PG8_SA(1, 0), cA + kstep, voffA); PG8_STAGE(PG8_SB(1, 1), cB + hstep + kstep, voffB);
        PG8_WAIT_V(6); PG8_BAR;
    }
    for (;;) {
        const bool has_next = S.next(ui + 1, nxt);
        const char* nA = has_next ? (const char*)g.A + (size_t)nxt.pm * tstep : cA; const char* nB = has_next ? (const char*)g.Bt + (size_t)nxt.pn * tstep : cB;
        for (int t = 0; t < nt; t += 2) {
            const bool last = (t == nt - 2);
            const char* a1 = cA + (size_t)(t + 1) * kstep;
            const char* a2 = last ? nA : cA + (size_t)(t + 2) * kstep; const char* b2 = last ? nB : cB + (size_t)(t + 2) * kstep;
            const char* a3 = a2 + kstep; const char* b3 = b2 + kstep;
            if (last && has_next) S.a_ready(nxt);
            if constexpr (SP2) {
            PG8_LDB(B0, 0, 0); PG8_LDB(B1, 0, 1); PG8_SCHED; PG8_LDA(At, 0, 0); PG8_STAGE(PG8_SA(1, 1), a1 + hstep, voffA);
            PG8_WAIT_V(8); PG8_WAIT_L(0); PG8_BAR; PG8_MMA(0, 0, At, B0); PG8_MMA(0, 1, At, B1); PG8_BAR; PG8_SCHED;
            PG8_LDA(At, 0, 1); PG8_STAGE(PG8_SB(0, 0), b2, voffB); PG8_STAGE(PG8_SB(0, 1), b2 + hstep, voffB); PG8_STAGE(PG8_SA(0, 0), a2, voffA);
            PG8_WAIT_V(8); PG8_WAIT_L(0); PG8_BAR; PG8_MMA(1, 0, At, B0); PG8_MMA(1, 1, At, B1); PG8_BAR; PG8_SCHED;
            PG8_LDB(B0, 1, 0); PG8_LDB(B1, 1, 1); PG8_SCHED; PG8_LDA(At, 1, 0); PG8_STAGE(PG8_SA(0, 1), a2 + hstep, voffA);
            PG8_WAIT_V(8); PG8_WAIT_L(0); PG8_BAR; PG8_MMA(0, 0, At, B0); PG8_MMA(0, 1, At, B1); PG8_BAR; PG8_SCHED;
            PG8_LDA(At, 1, 1); PG8_STAGE(PG8_SB(1, 0), b3, voffB); PG8_STAGE(PG8_SB(1, 1), b3 + hstep, voffB); PG8_STAGE(PG8_SA(1, 0), a3, voffA);
            PG8_WAIT_V(8); PG8_WAIT_L(0); PG8_BAR; PG8_MMA(1, 0, At, B0); PG8_MMA(1, 1, At, B1); PG8_BAR; PG8_SCHED;
            } else {
            PG8_LDB(B0, 0, 0); PG8_SCHED; PG8_LDA(At, 0, 0); PG8_STAGE(PG8_SA(1, 1), a1 + hstep, voffA);
            PG8_WAIT_L(8); PG8_BAR; PG8_WAIT_L(0); PG8_MMA(0, 0, At, B0); PG8_BAR; PG8_SCHED;
            PG8_LDB(B1, 0, 1); PG8_STAGE(PG8_SB(0, 0), b2, voffB);
            PG8_BAR; PG8_WAIT_L(0); PG8_MMA(0, 1, At, B1); PG8_BAR;
            PG8_LDA(At, 0, 1); PG8_STAGE(PG8_SA(0, 0), a2, voffA);
            PG8_BAR; PG8_WAIT_L(0); PG8_MMA(1, 0, At, B0); PG8_BAR; PG8_SCHED;
            PG8_STAGE(PG8_SB(0, 1), b2 + hstep, voffB);
            PG8_WAIT_V(6); PG8_BAR; PG8_MMA(1, 1, At, B1); PG8_BAR;
            PG8_LDB(B0, 1, 0); PG8_SCHED; PG8_LDA(At, 1, 0); PG8_STAGE(PG8_SA(0, 1), a2 + hstep, voffA);
            PG8_WAIT_L(8); PG8_BAR; PG8_WAIT_L(0); PG8_MMA(0, 0, At, B0); PG8_BAR; PG8_SCHED;
            PG8_LDB(B1, 1, 1); PG8_STAGE(PG8_SB(1, 0), b3, voffB);
            PG8_BAR; PG8_WAIT_L(0); PG8_MMA(0, 1, At, B1); PG8_BAR;
            PG8_LDA(At, 1, 1); PG8_STAGE(PG8_SA(1, 0), a3, voffA);
            PG8_BAR; PG8_WAIT_L(0); PG8_MMA(1, 0, At, B0); PG8_BAR; PG8_SCHED;
            PG8_STAGE(PG8_SB(1, 1), b3 + hstep, voffB);
            PG8_WAIT_V(6); PG8_BAR; PG8_MMA(1, 1, At, B1); PG8_BAR;
            }
        }
        if constexpr (ALIGN_EPI) { if (wr == 0) PG8_BAR; }
        if constexpr (!Epi::AFTER_DRAIN) { int l_e; asm volatile("v_mbcnt_lo_u32_b32 %0, -1, 0\n\tv_mbcnt_hi_u32_b32 %0, -1, %0" : "=v"(l_e)); const int fr_e = l_e & 15, fq_e = l_e >> 4;
            E(acc, cur, wr, wc, fr_e, fq_e); S.done(cur); }
        if (!has_next) break;
#pragma unroll
        for (int a = 0; a < 2; ++a)
#pragma unroll
            for (int b = 0; b < 2; ++b)
#pragma unroll
                for (int m = 0; m < 4; ++m)
#pragma unroll
                    for (int n = 0; n < 2; ++n) acc[a][b][m][n] = (f32x4){0.f, 0.f, 0.f, 0.f};
        cur = nxt; cA = nA; cB = nB; ++ui;
        if constexpr (ALIGN_EPI) { if (wr == 1) PG8_BAR; }
    }
    PG8_WAIT_V(0);
    if constexpr (!ALIGN_EPI) { if (wr == 0) PG8_BAR; }
    PG8_BAR;
    if constexpr (Epi::AFTER_DRAIN) { E.fused(acc, cur, wr, wc, fr, fq, lds, wid, lane); S.done(cur); }
#undef PG8_SA
#undef PG8_SB
#undef PG8_STAGE
#undef PG8_LDA
#undef PG8_LDB
#undef PG8_MMA
#undef PG8_WAIT_V
#undef PG8_WAIT_L
#undef PG8_BAR
#undef PG8_SCHED
}
}

#define LAS __attribute__((address_space(3)))
#define DEVI __device__ __forceinline__
typedef unsigned short bf16_t;
typedef short bf16x8 __attribute__((ext_vector_type(8)));
typedef short bf16x4 __attribute__((ext_vector_type(4)));
typedef float f32x4 __attribute__((ext_vector_type(4)));
typedef float f32x2 __attribute__((ext_vector_type(2)));
typedef unsigned u32x4 __attribute__((ext_vector_type(4)));
typedef unsigned u32x2 __attribute__((ext_vector_type(2)));
typedef __bf16 bf16v2 __attribute__((ext_vector_type(2)));
using pg8::Unit;

constexpr int DM = 1024, NP = 16384, NS = 128, MT = NP + NS, SEQ = 2048, NBATCH = 8, DEPTH = 4;
constexpr int INW = 2944, INP = 3072, FF = 4096;
constexpr int C_HQ = 0, C_HF = 384, C_HI = 768, C_HGG = 1152, C_RQ = 1536, C_RK = 1728, C_RV = 1920, C_RG = 2304, C_SU = 2688;
constexpr float LN_EPS = 1e-5f;
constexpr float ALPHA = 1.6817928305074290f;
constexpr int NSEG = 32, SEGL = 64;
constexpr int NU_HG = NBATCH * 6 * NSEG, NU_RT = NBATCH * 6 * NSEG, NU_S5 = NBATCH * 16 * NSEG;

constexpr size_t O_YP = 0, O_YS = 16777216, O_HGP = 16908288, O_RTP = 17694720, O_S5RP = 18087936, O_S5IP = 18120704,
                 O_HGS = 18153472, O_RTS = 30736384, O_S5RS = 37027840, O_S5IS = 37552128;
constexpr size_t MiB = 1u << 20;
constexpr size_t WS_ROPE = 0, WS_LB = 0x48000, WS_APOW = 0x50000, WS_GT = 0xE0000, WS_BB = 0xF0000, WS_CM = 0x130000;
constexpr size_t WS_WIN = 2 * MiB, WS_WOUT = 26 * MiB, WS_WUP = 34 * MiB, WS_WDN = 66 * MiB, WS_WGLU = 98 * MiB;
constexpr size_t WS_XB = 99 * MiB, WS_PROJ = 132 * MiB, WS_MIX = WS_PROJ + (size_t)MT * INP * 2, WS_HID = WS_PROJ;
constexpr size_t WS_Y5 = 262 * MiB, WS_SHG = 271 * MiB, WS_DHG = 295 * MiB, WS_SRT = 296 * MiB, WS_XS5 = 308 * MiB, WS_END = 310 * MiB;
static_assert(WS_MIX + (size_t)MT * DM * 2 <= WS_Y5, "ws map");
constexpr int LDS_BYTES = 147456;

struct Args { const float* in[27]; float* out; unsigned char* ws; };

DEVI float bf2f(bf16_t b) { return __uint_as_float(((unsigned)b) << 16); }
DEVI unsigned pk2(float lo, float hi) { f32x2 v = {lo, hi}; bf16v2 b = __builtin_convertvector(v, bf16v2); return __builtin_bit_cast(unsigned, b); }
DEVI bf16_t f2bf1(float f) { return (bf16_t)(pk2(f, 0.f) & 0xffffu); }
DEVI bf16x4 cvt4(f32x4 v) { u32x2 w; w.x = pk2(v[0], v[1]); w.y = pk2(v[2], v[3]); return __builtin_bit_cast(bf16x4, w); }
DEVI float rcpf(float x) { return __builtin_amdgcn_rcpf(x); }
DEVI float siluf(float x) { return x * rcpf(1.f + __expf(-x)); }
template <int C> DEVI float dpp_f(float x) { return __int_as_float(__builtin_amdgcn_update_dpp(0, __float_as_int(x), C, 0xF, 0xF, false)); }
DEVI float row16_sum(float v) { v += dpp_f<0x128>(v); v += dpp_f<0x124>(v); v += dpp_f<0x122>(v); v += dpp_f<0x121>(v); return v; }
DEVI float rdlane(float v, int l) { return __int_as_float(__builtin_amdgcn_readlane(__float_as_int(v), l)); }
DEVI float wave_sum(float v) { v = row16_sum(v); return (rdlane(v, 0) + rdlane(v, 16)) + (rdlane(v, 32) + rdlane(v, 48)); }
DEVI float bperm(float v, int src) { return __int_as_float(__builtin_amdgcn_ds_bpermute(src << 2, __float_as_int(v))); }
template <int D> DEVI float dpp_shr(float x) { return __int_as_float(__builtin_amdgcn_update_dpp(0, __float_as_int(x), 0x110 + D, 0xF, 0xF, false)); }
#define MFMA16(a, b, c) __builtin_amdgcn_mfma_f32_16x16x16bf16_1k((a), (b), (c), 0, 0, 0)
#define LDSW() asm volatile("s_waitcnt lgkmcnt(0)" ::: "memory")
DEVI int hw_lane() { int l; asm volatile("v_mbcnt_lo_u32_b32 %0, -1, 0\n\tv_mbcnt_hi_u32_b32 %0, -1, %0" : "=v"(l)); return l; }

template <int ACT> struct EpiBf {
    static constexpr bool PERM = true, AFTER_DRAIN = false;
    bf16_t* O; int ldc; int coff; const bf16_t* Y; const float* bias;
    DEVI void apply8(int row, int col, f32x4 v0, f32x4 v1) const {
        if (ACT == 2) {
#pragma unroll
            for (int i = 0; i < 4; ++i) { float a = fmaxf(v0[i], 0.f), b = fmaxf(v1[i], 0.f); v0[i] = a * a; v1[i] = b * b; }
        }
        if (ACT == 3) {
            const u32x4 yw = *(const u32x4*)(Y + (size_t)row * 256 + col);
            const f32x4 b0 = *(const f32x4*)(bias + col), b1 = *(const f32x4*)(bias + col + 4);
#pragma unroll
            for (int i = 0; i < 4; ++i) {
                const unsigned w0 = yw[i >> 1], w1 = yw[2 + (i >> 1)];
                const float y0 = (i & 1) ? __uint_as_float(w0 & 0xffff0000u) : __uint_as_float(w0 << 16);
                const float y1 = (i & 1) ? __uint_as_float(w1 & 0xffff0000u) : __uint_as_float(w1 << 16);
                v0[i] = y0 * rcpf(1.f + __expf(-(v0[i] + b0[i])));
                v1[i] = y1 * rcpf(1.f + __expf(-(v1[i] + b1[i])));
            }
        }
        u32x4 w; w.x = pk2(v0[0], v0[1]); w.y = pk2(v0[2], v0[3]); w.z = pk2(v1[0], v1[1]); w.w = pk2(v1[2], v1[3]);
        *(u32x4*)(O + (size_t)row * ldc + coff + col) = w;
    }
    DEVI void operator()(const f32x4 (&acc)[2][2][4][2], const Unit& u, int wr, int wc, int fr, int fq) const {
        const int row0 = u.pm * 256 + wr * 64 + fr, col0 = u.pn * 256 + wc * 32 + 8 * fq;
#pragma unroll
        for (int ai = 0; ai < 2; ++ai)
#pragma unroll
            for (int m = 0; m < 4; ++m)
#pragma unroll
                for (int bj = 0; bj < 2; ++bj) { apply8(row0 + ai * 128 + m * 16, col0 + bj * 128, acc[ai][bj][m][0], acc[ai][bj][m][1]); if (ACT == 3) asm volatile("" ::: "memory"); }
    }
    DEVI void elem4(int row, int col, f32x4 v) const {
        if (ACT == 2) {
#pragma unroll
            for (int i = 0; i < 4; ++i) { float a = fmaxf(v[i], 0.f); v[i] = a * a; }
        }
        if (ACT == 3) {
            const u32x2 yw = *(const u32x2*)(Y + (size_t)row * 256 + col);
            const f32x4 b0 = *(const f32x4*)(bias + col);
#pragma unroll
            for (int i = 0; i < 4; ++i) {
                const unsigned w0 = yw[i >> 1];
                const float y0 = (i & 1) ? __uint_as_float(w0 & 0xffff0000u) : __uint_as_float(w0 << 16);
                v[i] = y0 * rcpf(1.f + __expf(-(v[i] + b0[i])));
            }
        }
        u32x2 w; w.x = pk2(v[0], v[1]); w.y = pk2(v[2], v[3]);
        *(u32x2*)(O + (size_t)row * ldc + coff + col) = w;
    }
};
struct EpiRes {
    static constexpr bool PERM = false, AFTER_DRAIN = false;
    const float* base; float* out; const float* sbase; float* sout;
    DEVI void operator()(const f32x4 (&acc)[2][2][4][2], const Unit& u, int wr, int wc, int fr, int fq) const {
        const int row0 = u.pm * 256 + wr * 64 + fr, col0 = u.pn * 256 + wc * 32 + 4 * fq;
#pragma unroll
        for (int ai = 0; ai < 2; ++ai)
#pragma unroll
            for (int m = 0; m < 4; ++m) {
                const size_t ro = (size_t)(row0 + ai * 128 + m * 16) * DM;
#pragma unroll
                for (int bj = 0; bj < 2; ++bj)
#pragma unroll
                    for (int n = 0; n < 2; ++n) {
                        const size_t o = ro + col0 + bj * 128 + n * 16;
                        const f32x4 b = *(const f32x4*)(base + o);
                        *(f32x4*)(out + o) = b * ALPHA + acc[ai][bj][m][n];
                    }
                asm volatile("" ::: "memory");
            }
    }
    DEVI void elem4(int row, int col, f32x4 v) const {
        const size_t o = (size_t)(row - NP) * DM + col;
        const f32x4 b = *(const f32x4*)(sbase + o);
        *(f32x4*)(sout + o) = b * ALPHA + v;
    }
};

template <class Epi> DEVI void sample_gemm(const bf16_t* A, const bf16_t* Bt, int N, int K, const Epi& E, int wave, int bx, int Gp) {
    const int lane = hw_lane();
    const int fr = lane & 15, fq = lane >> 4;
    const bf16_t* ap = A + (size_t)(NP + wave * 16 + fr) * K + fq * 8;
    for (int u = bx; u < N / 16; u += Gp) {
        const bf16_t* bp = Bt + (size_t)(u * 16 + fr) * K + fq * 8;
        f32x4 acc = {0.f, 0.f, 0.f, 0.f};
#pragma unroll 8
        for (int k = 0; k < K; k += 32) {
            const bf16x8 a = *(const bf16x8*)(ap + k), b = *(const bf16x8*)(bp + k);
            acc = __builtin_amdgcn_mfma_f32_16x16x32_bf16(b, a, acc, 0, 0, 0);
        }
        E.elem4(NP + wave * 16 + fr, u * 16 + fq * 4, acc);
    }
}

DEVI void transpose_item(const float* W, int K, int N, bf16_t* WT, LAS float* scr, int item, int lane) {
    const int nblk = N / 32, kb = item / nblk, nb = item % nblk, k0 = 64 * kb, n0 = 32 * nb;
#pragma unroll 8
    for (int i = 0; i < 32; ++i) { const int kk = 2 * i + (lane >> 5); scr[kk * 33 + (lane & 31)] = W[(size_t)(k0 + kk) * N + n0 + (lane & 31)]; }
    LDSW();
    const int c = lane & 7;
#pragma unroll
    for (int j = 0; j < 4; ++j) { const int n = (lane >> 3) + 8 * j; const LAS float* s = scr + (8 * c) * 33 + n;
        u32x4 o; o.x = pk2(s[0 * 33], s[1 * 33]); o.y = pk2(s[2 * 33], s[3 * 33]); o.z = pk2(s[4 * 33], s[5 * 33]); o.w = pk2(s[6 * 33], s[7 * 33]);
        *(u32x4*)(WT + (size_t)(n0 + n) * K + k0 + 8 * c) = o; }
    LDSW();
}
DEVI void sincos_rev(double ang, float& s, float& c) {
    const double rev = ang * 0.15915494309189535; const float fr = (float)(rev - rint(rev));
    s = __builtin_amdgcn_sinf(fr); c = __builtin_amdgcn_cosf(fr);
}
DEVI void prologue(const Args& a, LAS unsigned char* lds, int wave, int lane, int gw, int ngw) {
    lane = hw_lane();
    unsigned char* ws = a.ws;
    LAS float* scr = (LAS float*)(lds + wave * 16384);
    constexpr int I_IN = 16 * 92, I_OUT = 16 * 32, I_UP = 16 * 128, I_DN = 64 * 32, I_GL = 4 * 8, I_L = I_IN + I_OUT + I_UP + I_DN + I_GL;
    for (int it = gw; it < DEPTH * I_L; it += ngw) {
        const int l = it / I_L; int r = it % I_L;
        if (r < I_IN) { transpose_item(a.in[6] + (size_t)l * DM * INW, DM, INW, (bf16_t*)(ws + WS_WIN) + (size_t)l * INP * DM, scr, r, lane); continue; } r -= I_IN;
        if (r < I_OUT) { transpose_item(a.in[20] + (size_t)l * DM * DM, DM, DM, (bf16_t*)(ws + WS_WOUT) + (size_t)l * DM * DM, scr, r, lane); continue; } r -= I_OUT;
        if (r < I_UP) { transpose_item(a.in[23] + (size_t)l * DM * FF, DM, FF, (bf16_t*)(ws + WS_WUP) + (size_t)l * FF * DM, scr, r, lane); continue; } r -= I_UP;
        if (r < I_DN) { transpose_item(a.in[24] + (size_t)l * FF * DM, FF, DM, (bf16_t*)(ws + WS_WDN) + (size_t)l * DM * FF, scr, r, lane); continue; } r -= I_DN;
        transpose_item(a.in[18] + (size_t)l * 256 * 256, 256, 256, (bf16_t*)(ws + WS_WGLU) + (size_t)l * 256 * 256, scr, r, lane);
    }
    bf16_t* XB = (bf16_t*)(ws + WS_XB);
    for (int row = gw; row < MT; row += ngw) {
        const float* src = row < NP ? a.in[0] + (size_t)row * DM : a.in[1] + (size_t)(row - NP) * DM;
#pragma unroll
        for (int j = 0; j < 4; ++j) { const f32x4 v = *((const f32x4*)src + lane + 64 * j); u32x2 w; w.x = pk2(v[0], v[1]); w.y = pk2(v[2], v[3]);
            *((u32x2*)(XB + (size_t)row * DM) + lane + 64 * j) = w; }
    }
    const int gt = gw * 64 + lane, ngt = ngw * 64;
    f32x2* ROPE = (f32x2*)(ws + WS_ROPE);
    for (int i = gt; i < 2049 * 16; i += ngt) {
        const int p = i >> 4, f = i & 15; const float pos = p < 2048 ? (float)p : 16384.f;
        const float inv = exp2f(-(float)f * 0.83048202372184059f);
        float s, c; sincos_rev((double)pos * (double)inv, s, c);
        ROPE[i] = (f32x2){c, s};
    }
    float* LB = (float*)(ws + WS_LB);
    for (int i = gt; i < 384; i += ngt) {
        const float l0 = a.in[7][i], l1 = a.in[7][384 + i], l2 = a.in[7][768 + i], l3 = a.in[7][1152 + i];
        const float mx = fmaxf(fmaxf(l0, l1), fmaxf(l2, l3));
        const float e0 = expf(l0 - mx), e1 = expf(l1 - mx), e2 = expf(l2 - mx), e3 = expf(l3 - mx), inv = 1.f / (e0 + e1 + e2 + e3);
        LB[i] = 0.f; LB[384 + i] = e1 * inv; LB[768 + i] = (e1 + e2) * inv; LB[1152 + i] = (e1 + e2 + e3) * inv;
    }
    f32x2* APOW = (f32x2*)(ws + WS_APOW); f32x2* GT = (f32x2*)(ws + WS_GT); bf16_t* BB = (bf16_t*)(ws + WS_BB); bf16_t* CM = (bf16_t*)(ws + WS_CM);
    for (int i = gt; i < DEPTH * 16 * 64; i += ngt) {
        const int lg = i >> 6, n = i & 63;
        const float dt = expf(a.in[10][lg]); const float are = a.in[11][i], aim = a.in[12][i];
        float abr = 0.f, abi = 0.f;
        for (int m = 1; m <= 17; ++m) {
            const int mm = m <= 16 ? m : 64;
            const float mag = expf((float)mm * dt * are); float s, c; sincos_rev((double)mm * (double)dt * (double)aim, s, c);
            APOW[(size_t)(lg * 17 + (m - 1)) * 64 + n] = (f32x2){mag * c, mag * s};
            if (m == 1) { abr = mag * c; abi = mag * s; }
        }
        const float den = are * are + aim * aim, nr = abr - 1.f;
        const float gr = (nr * are + abi * aim) / den, gi = (abi * are - nr * aim) / den;
        GT[i] = (f32x2){gr, gi};
        const float* bre = a.in[13] + (size_t)i * 16; const float* bim = a.in[14] + (size_t)i * 16;
#pragma unroll
        for (int c2 = 0; c2 < 16; c2 += 2) {
            const float r0 = bre[c2], r1 = bre[c2 + 1], i0 = bim[c2], i1 = bim[c2 + 1];
            *(unsigned*)(BB + ((size_t)lg * 128 + n) * 16 + c2) = pk2(gr * r0 - gi * i0, gr * r1 - gi * i1);
            *(unsigned*)(BB + ((size_t)lg * 128 + 64 + n) * 16 + c2) = pk2(gr * i0 + gi * r0, gr * i1 + gi * r1);
        }
    }
    for (int i = gt; i < DEPTH * 16 * 16 * 128; i += ngt) {
        const int nn = i & 127, lgc = i >> 7;
        const float v = nn < 64 ? a.in[15][(size_t)lgc * 64 + nn] : -a.in[16][(size_t)lgc * 64 + nn - 64];
        CM[i] = f2bf1(v);
    }
}

DEVI void ln_phase(float* xf, const float* w, const float* b, bf16_t* xb, int lane, int gw, int ngw) {
    lane = hw_lane();
    for (int row = gw; row < MT; row += ngw) {
        f32x4* xr = (f32x4*)(xf + (size_t)row * DM) + lane;
        f32x4 v[4]; float s = 0.f;
#pragma unroll
        for (int j = 0; j < 4; ++j) { v[j] = xr[64 * j]; s += (v[j][0] + v[j][1]) + (v[j][2] + v[j][3]); }
        const float mean = wave_sum(s) * (1.f / DM); float s2 = 0.f;
#pragma unroll
        for (int j = 0; j < 4; ++j) { v[j] = v[j] - mean; s2 += (v[j][0] * v[j][0] + v[j][1] * v[j][1]) + (v[j][2] * v[j][2] + v[j][3] * v[j][3]); }
        const float rstd = 1.f / sqrtf(wave_sum(s2) * (1.f / DM) + LN_EPS);
#pragma unroll
        for (int j = 0; j < 4; ++j) {
            const f32x4 wv = *((const f32x4*)w + lane + 64 * j), bv = *((const f32x4*)b + lane + 64 * j);
            const f32x4 o = v[j] * rstd * wv + bv;
            xr[64 * j] = o;
            u32x2 pw; pw.x = pk2(o[0], o[1]); pw.y = pk2(o[2], o[3]);
            *((u32x2*)(xb + (size_t)row * DM) + lane + 64 * j) = pw;
        }
    }
}

DEVI bf16x4 ld4rows(const LAS bf16_t* p) {
    const unsigned a = p[0], b = p[72], c = p[144], d = p[216];
    u32x2 w; w.x = a | (b << 16); w.y = c | (d << 16); return __builtin_bit_cast(bf16x4, w);
}
template <int DK, bool HG, bool PC>
DEVI void la_unit(const Args& a, unsigned char* wsx, LAS unsigned char* wl, int lane, int layer, int h, const bf16_t* pr0, int pos0, float* sbuf, float* dbuf, bf16_t* mix0) {
    constexpr int NKT = DK / 16;
    constexpr int QOFF = HG ? C_HQ : C_RQ, KOFF = HG ? C_HF : C_RK, VOFF = HG ? C_HI : C_RV, GOFF = HG ? C_HGG : C_RG;
    const int fr = lane & 15, fq = lane >> 4;
    LAS bf16_t* QS = (LAS bf16_t*)wl; LAS bf16_t* KS = (LAS bf16_t*)(wl + 2304); LAS bf16_t* KT = (LAS bf16_t*)(wl + 4608);
    LAS bf16_t* VR = (LAS bf16_t*)(wl + 6912); LAS bf16_t* GR = (LAS bf16_t*)(wl + 9216); LAS float* CD = (LAS float*)(wl + 11520);
    LAS bf16_t* OS = KT;
    const unsigned char* ws = wsx;
    f32x4 S[NKT][4];
#pragma unroll
    for (int kt = 0; kt < NKT; ++kt)
#pragma unroll
        for (int vt = 0; vt < 4; ++vt)
#pragma unroll
            for (int j = 0; j < 4; ++j) S[kt][vt][j] = PC ? sbuf[(kt * 16 + fq * 4 + j) * 64 + vt * 16 + fr] : 0.f;
    float btot = 0.f;
    float lb = 0.f, oml = 1.f, lg = 0.f;
    if (HG) { lb = ((const float*)(ws + WS_LB))[layer * 384 + h * 64 + lane]; oml = 1.f - lb; }
    else { lg = log1pf(-exp2f(-5.f - (float)h)); }
    const f32x2* ROPE = (const f32x2*)(ws + WS_ROPE);
    float nw[4];
#pragma unroll
    for (int vt = 0; vt < 4; ++vt) nw[vt] = HG ? a.in[8][layer * 64 + vt * 16 + fr] : a.in[9][layer * 384 + h * 64 + vt * 16 + fr];
    const int r8 = lane >> 3, c8 = lane & 7, r4 = lane >> 2, c4 = lane & 3;
    const int g64 = r8 * INP + c8 * 8, l64 = r8 * 72 + c8 * 8, g32 = r4 * INP + c4 * 8, l32 = r4 * 72 + c4 * 8;
    const int kidx = lane & 31, tp = lane >> 5, ri = kidx & 15; const bool lo = kidx < 16;
    u32x4 pz[2], pq[2], pv[2], pg[2]; f32x2 pcs[8];
#define LA_LOAD(c) do { const bf16_t* p_ = pr0 + (size_t)(c) * 16 * INP; \
        if (HG) { pz[0] = *(const u32x4*)(p_ + g64 + KOFF + h * 64); pz[1] = *(const u32x4*)(p_ + g64 + 8 * INP + KOFF + h * 64); \
                  if (PC) { pq[0] = *(const u32x4*)(p_ + g64 + QOFF + h * 64); pq[1] = *(const u32x4*)(p_ + g64 + 8 * INP + QOFF + h * 64); } } \
        else { pz[0] = *(const u32x4*)(p_ + g32 + KOFF + h * 32); if (PC) pq[0] = *(const u32x4*)(p_ + g32 + QOFF + h * 32); \
               _Pragma("unroll") for (int it = 0; it < 8; ++it) pcs[it] = ROPE[(pos0 + (c) * 16 + 2 * it + tp) * 16 + ri]; } \
        pv[0] = *(const u32x4*)(p_ + g64 + VOFF + h * 64); pv[1] = *(const u32x4*)(p_ + g64 + 8 * INP + VOFF + h * 64); \
        if (PC) { pg[0] = *(const u32x4*)(p_ + g64 + GOFF + h * 64); pg[1] = *(const u32x4*)(p_ + g64 + 8 * INP + GOFF + h * 64); } } while (0)
    LA_LOAD(0);
    for (int c = 0; c < 4; ++c) {
        if (HG) { *(LAS u32x4*)(KS + l64) = pz[0]; *(LAS u32x4*)(KS + l64 + 8 * 72) = pz[1];
                  if (PC) { *(LAS u32x4*)(QS + l64) = pq[0]; *(LAS u32x4*)(QS + l64 + 8 * 72) = pq[1]; } }
        else { *(LAS u32x4*)(KS + l32) = pz[0]; if (PC) *(LAS u32x4*)(QS + l32) = pq[0]; }
        *(LAS u32x4*)(VR + l64) = pv[0]; *(LAS u32x4*)(VR + l64 + 8 * 72) = pv[1];
        if (PC) { *(LAS u32x4*)(GR + l64) = pg[0]; *(LAS u32x4*)(GR + l64 + 8 * 72) = pg[1]; }
        f32x2 cs[8];
        if (!HG) {
#pragma unroll
            for (int it = 0; it < 8; ++it) cs[it] = pcs[it];
        }
        if (c < 3) LA_LOAD(c + 1);
        LDSW();
        if (HG) {
            float lf[16], kv[16]; float b15 = 0.f;
#pragma unroll
            for (int t = 0; t < 16; ++t) {
                float z = bf2f(KS[t * 72 + lane]); z = fminf(fmaxf(z, -30.f), 30.f);
                const float e = __expf(-z), sg = rcpf(1.f + e);
                lf[t] = __logf(lb + oml * sg); kv[t] = oml * e * sg; b15 += lf[t];
            }
            float b = 0.f;
#pragma unroll
            for (int t = 0; t < 16; ++t) {
                b += lf[t];
                if (PC) {
                    const float q = siluf(bf2f(QS[t * 72 + lane]));
                    QS[t * 72 + lane] = f2bf1(q * __expf(b));
                    KS[t * 72 + lane] = f2bf1(kv[t] * __expf(fminf(-b, 80.f)));
                }
                KT[t * 72 + lane] = f2bf1(kv[t] * __expf(b15 - b));
            }
            CD[lane] = __expf(b15); btot += b15;
        } else {
#pragma unroll
            for (int it = 0; it < 8; ++it) {
                const int t = 2 * it + tp; const float tf = (float)(t + 1);
                const float xk = bf2f(KS[t * 72 + kidx]), xkp = bf2f(KS[t * 72 + (kidx ^ 16)]);
                const float k = (lo ? xk * cs[it][0] - xkp * cs[it][1] : xkp * cs[it][1] + xk * cs[it][0]) * 0.17677669529663687f;
                float q = 0.f;
                if (PC) { const float xq = bf2f(QS[t * 72 + kidx]), xqp = bf2f(QS[t * 72 + (kidx ^ 16)]); q = lo ? xq * cs[it][0] - xqp * cs[it][1] : xqp * cs[it][1] + xq * cs[it][0]; }
                KT[t * 72 + kidx] = f2bf1(k * __expf((16.f - tf) * lg));
                if (PC) { QS[t * 72 + kidx] = f2bf1(q * __expf(tf * lg)); KS[t * 72 + kidx] = f2bf1(k * __expf(-tf * lg)); }
            }
            if (lane < 32) CD[lane] = __expf(16.f * lg);
        }
        LDSW();
        bf16x4 vf[4], ktf[NKT];
#pragma unroll
        for (int vt = 0; vt < 4; ++vt) vf[vt] = ld4rows(VR + fq * 4 * 72 + vt * 16 + fr);
#pragma unroll
        for (int kt = 0; kt < NKT; ++kt) ktf[kt] = ld4rows(KT + fq * 4 * 72 + kt * 16 + fr);
        f32x4 O[4];
        if (PC) {
            bf16x4 qf[NKT], kf[NKT];
#pragma unroll
            for (int kt = 0; kt < NKT; ++kt) { qf[kt] = *(const LAS bf16x4*)(QS + fr * 72 + kt * 16 + fq * 4); kf[kt] = *(const LAS bf16x4*)(KS + fr * 72 + kt * 16 + fq * 4); }
            f32x4 sc = {0.f, 0.f, 0.f, 0.f};
#pragma unroll
            for (int kt = 0; kt < NKT; ++kt) sc = MFMA16(kf[kt], qf[kt], sc);
#pragma unroll
            for (int j = 0; j < 4; ++j) if (fq * 4 + j > fr) sc[j] = 0.f;
            const bf16x4 pf = cvt4(sc);
#pragma unroll
            for (int vt = 0; vt < 4; ++vt) {
                f32x4 o = {0.f, 0.f, 0.f, 0.f};
#pragma unroll
                for (int kt = 0; kt < NKT; ++kt) o = MFMA16(qf[kt], cvt4(S[kt][vt]), o);
                O[vt] = MFMA16(pf, vf[vt], o);
            }
        }
#pragma unroll
        for (int kt = 0; kt < NKT; ++kt) {
            const f32x4 cd4 = *(const LAS f32x4*)(CD + kt * 16 + fq * 4);
#pragma unroll
            for (int vt = 0; vt < 4; ++vt) S[kt][vt] = MFMA16(ktf[kt], vf[vt], S[kt][vt] * cd4);
        }
        if (PC) {
            float rs[4], mu[4];
#pragma unroll
            for (int j = 0; j < 4; ++j) {
                if (HG) {
                    float ss = (O[0][j] * O[0][j] + O[1][j] * O[1][j]) + (O[2][j] * O[2][j] + O[3][j] * O[3][j]);
                    ss = row16_sum(ss); mu[j] = 0.f; rs[j] = rsqrtf(ss * (1.f / 64.f) + LN_EPS);
                } else {
                    float sm = (O[0][j] + O[1][j]) + (O[2][j] + O[3][j]); sm = row16_sum(sm); mu[j] = sm * (1.f / 64.f);
                    const float d0 = O[0][j] - mu[j], d1 = O[1][j] - mu[j], d2 = O[2][j] - mu[j], d3 = O[3][j] - mu[j];
                    float ss = (d0 * d0 + d1 * d1) + (d2 * d2 + d3 * d3); ss = row16_sum(ss); rs[j] = rsqrtf(ss * (1.f / 64.f) + LN_EPS);
                }
            }
#pragma unroll
            for (int vt = 0; vt < 4; ++vt)
#pragma unroll
                for (int j = 0; j < 4; ++j) {
                    const int t = fq * 4 + j, v = vt * 16 + fr;
                    const float gte = siluf(bf2f(GR[t * 72 + v]));
                    OS[t * 72 + v] = f2bf1((O[vt][j] - mu[j]) * rs[j] * nw[vt] * gte);
                }
            LDSW();
            bf16_t* mp = mix0 + (size_t)(c * 16 + r8) * DM + (HG ? 0 : 384) + h * 64 + c8 * 8;
            const u32x4 o0 = *(const LAS u32x4*)(OS + l64), o1 = *(const LAS u32x4*)(OS + l64 + 8 * 72);
            *(u32x4*)mp = o0; *(u32x4*)(mp + 8 * DM) = o1;
        }
    }
#undef LA_LOAD
    if (!PC) {
#pragma unroll
        for (int kt = 0; kt < NKT; ++kt)
#pragma unroll
            for (int vt = 0; vt < 4; ++vt)
#pragma unroll
                for (int j = 0; j < 4; ++j) sbuf[(kt * 16 + fq * 4 + j) * 64 + vt * 16 + fr] = S[kt][vt][j];
        if (HG) dbuf[lane] = __expf(btot);
    }
}

template <bool PC>
DEVI void s5_unit(const Args& a, unsigned char* wsx, LAS unsigned char* wl, int lane, int layer, int g, const bf16_t* pr0, float* xbuf, bf16_t* y50) {
    const int fr = lane & 15, fq = lane >> 4, lgi = layer * 16 + g;
    const unsigned char* ws = wsx;
    const bf16_t* BB = (const bf16_t*)(ws + WS_BB) + (size_t)lgi * 128 * 16;
    const bf16_t* CM = (const bf16_t*)(ws + WS_CM) + (size_t)lgi * 16 * 128;
    const f32x2* APOW = (const f32x2*)(ws + WS_APOW) + (size_t)lgi * 17 * 64;
    bf16x4 bbf[8], cmf[8];
#pragma unroll
    for (int r = 0; r < 8; ++r) bbf[r] = *(const bf16x4*)(BB + (r * 16 + fr) * 16 + fq * 4);
    if (PC) {
#pragma unroll
        for (int s = 0; s < 8; ++s) cmf[s] = *(const bf16x4*)(CM + fr * 128 + s * 16 + fq * 4);
    }
#pragma unroll
    for (int i = 0; i < 8; ++i) { const int ch = lane + 64 * i, row = ch >> 5, c16 = ch & 31;
        *(LAS u32x4*)(wl + row * 528 + c16 * 16) = *(const u32x4*)((const unsigned char*)APOW + row * 512 + c16 * 16); }
    float xnr[4][4], xni[4][4];
#pragma unroll
    for (int r = 0; r < 4; ++r)
#pragma unroll
        for (int j = 0; j < 4; ++j) {
            const int n = r * 16 + fq * 4 + j;
            xnr[r][j] = PC ? xbuf[n] : 0.f; xni[r][j] = PC ? xbuf[64 + n] : 0.f;
        }
    f32x4 dd = {0.f, 0.f, 0.f, 0.f};
    if (PC) dd = *(const f32x4*)(a.in[17] + layer * 256 + g * 16 + fq * 4);
    LDSW();
    bf16x4 ufn = *(const bf16x4*)(pr0 + (size_t)fr * INP + C_SU + g * 16 + fq * 4);
    for (int c = 0; c < 4; ++c) {
        const bf16x4 uf = ufn;
        if (c < 3) ufn = *(const bf16x4*)(pr0 + (size_t)((c + 1) * 16 + fr) * INP + C_SU + g * 16 + fq * 4);
        const f32x4 z4 = {0.f, 0.f, 0.f, 0.f};
        f32x4 xr[4], xi[4];
#pragma unroll
        for (int r = 0; r < 4; ++r) { xr[r] = MFMA16(bbf[r], uf, z4); xi[r] = MFMA16(bbf[r + 4], uf, z4); }
        int tof = fq * 32; asm volatile("" : "+v"(tof));
        f32x2 m[4][4];
#pragma unroll
        for (int r = 0; r < 4; ++r) { const f32x4 t0 = *(const LAS f32x4*)(wl + r * 128 + tof), t1 = *(const LAS f32x4*)(wl + r * 128 + tof + 16);
            m[r][0] = (f32x2){t0[0], t0[1]}; m[r][1] = (f32x2){t0[2], t0[3]}; m[r][2] = (f32x2){t1[0], t1[1]}; m[r][3] = (f32x2){t1[2], t1[3]}; }
#define S5_STEP(D) do { _Pragma("unroll") for (int r = 0; r < 4; ++r) _Pragma("unroll") for (int j = 0; j < 4; ++j) { \
            const float pr_ = dpp_shr<D>(xr[r][j]), pi_ = dpp_shr<D>(xi[r][j]); \
            xr[r][j] += m[r][j][0] * pr_ - m[r][j][1] * pi_; xi[r][j] += m[r][j][0] * pi_ + m[r][j][1] * pr_; } } while (0)
#define S5_SQ() do { _Pragma("unroll") for (int r = 0; r < 4; ++r) _Pragma("unroll") for (int j = 0; j < 4; ++j) { \
            const float mr = m[r][j][0], mi = m[r][j][1]; m[r][j][0] = mr * mr - mi * mi; m[r][j][1] = 2.f * mr * mi; } } while (0)
        S5_STEP(1); S5_SQ(); S5_STEP(2); S5_SQ(); S5_STEP(4); S5_SQ(); S5_STEP(8);
#undef S5_STEP
#undef S5_SQ
#pragma unroll
        for (int r = 0; r < 4; ++r) {
            const f32x4 t0 = *(const LAS f32x4*)(wl + fr * 528 + r * 128 + tof), t1 = *(const LAS f32x4*)(wl + fr * 528 + r * 128 + tof + 16);
            const float pwr[4] = {t0[0], t0[2], t1[0], t1[2]}, pwi[4] = {t0[1], t0[3], t1[1], t1[3]};
#pragma unroll
            for (int j = 0; j < 4; ++j) {
                xr[r][j] += pwr[j] * xnr[r][j] - pwi[j] * xni[r][j];
                xi[r][j] += pwr[j] * xni[r][j] + pwi[j] * xnr[r][j];
            }
        }
#pragma unroll
        for (int r = 0; r < 4; ++r)
#pragma unroll
            for (int j = 0; j < 4; ++j) { xnr[r][j] = bperm(xr[r][j], (lane & 48) | 15); xni[r][j] = bperm(xi[r][j], (lane & 48) | 15); }
        if (PC) {
            f32x4 y = {0.f, 0.f, 0.f, 0.f};
#pragma unroll
            for (int s = 0; s < 4; ++s) { y = MFMA16(cmf[s], cvt4(xr[s]), y); y = MFMA16(cmf[s + 4], cvt4(xi[s]), y); }
            f32x4 o;
#pragma unroll
            for (int j = 0; j < 4; ++j) {
                const float x = y[j] + dd[j] * bf2f((bf16_t)uf[j]);
                o[j] = x * rcpf(1.f + __expf(-1.5957691216057308f * (x + 0.044715f * x * x * x)));
            }
            *(bf16x4*)(y50 + (size_t)(c * 16 + fr) * 256 + g * 16 + fq * 4) = cvt4(o);
        }
    }
    if (!PC && fr == 15) {
#pragma unroll
        for (int r = 0; r < 4; ++r)
#pragma unroll
            for (int j = 0; j < 4; ++j) { const int n = r * 16 + fq * 4 + j; xbuf[n] = xnr[r][j]; xbuf[64 + n] = xni[r][j]; }
    }
}

template <bool PC>
DEVI void mixer_pass(const Args& a, unsigned char* wsx, LAS unsigned char* lds, int wave, int lane, int gw, int ngw, int layer) {
    lane = hw_lane();
    unsigned char* ws = wsx;
    const bf16_t* PROJ = (const bf16_t*)(ws + WS_PROJ); bf16_t* MIX = (bf16_t*)(ws + WS_MIX); bf16_t* Y5 = (bf16_t*)(ws + WS_Y5);
    LAS unsigned char* wl = lds + wave * 16384;
#ifndef NO_HG
    for (int u = gw; u < NU_HG; u += ngw) {
        const int seg = u & 31, bh = u >> 5, b = bh / 6, h = bh % 6; const size_t row = (size_t)b * SEQ + seg * SEGL;
        la_unit<64, true, PC>(a, ws, wl, lane, layer, h, PROJ + row * INP, seg * SEGL, (float*)(ws + WS_SHG) + (size_t)u * 4096, (float*)(ws + WS_DHG) + (size_t)u * 64, MIX + row * DM);
    }
#endif
    asm volatile("" : "+v"(lane));
#ifndef NO_RT
    for (int u = gw >= NU_HG ? gw : gw + ((NU_HG - gw + ngw - 1) / ngw) * ngw; u < NU_HG + NU_RT; u += ngw) {
        const int v = u - NU_HG, seg = v & 31, bh = v >> 5, b = bh / 6, h = bh % 6; const size_t row = (size_t)b * SEQ + seg * SEGL;
        la_unit<32, false, PC>(a, ws, wl, lane, layer, h, PROJ + row * INP, seg * SEGL, (float*)(ws + WS_SRT) + (size_t)v * 2048, nullptr, MIX + row * DM);
    }
#endif
    asm volatile("" : "+v"(lane));
#ifndef NO_S5
    for (int u = gw >= NU_HG + NU_RT ? gw : gw + ((NU_HG + NU_RT - gw + ngw - 1) / ngw) * ngw; u < NU_HG + NU_RT + NU_S5; u += ngw) {
        const int v = u - NU_HG - NU_RT, seg = v & 31, bg = v >> 5, b = bg >> 4, g = bg & 15; const size_t row = (size_t)b * SEQ + seg * SEGL;
        int ln = lane; asm volatile("" : "+v"(ln));
        s5_unit<PC>(a, ws, wl, ln, layer, g, PROJ + row * INP, (float*)(ws + WS_XS5) + (size_t)v * 128, Y5 + row * 256);
    }
#endif
}

DEVI void mixer_pass_b(const Args& a, unsigned char* wsx, int wave, int lane, int gw, int ngw, int layer) {
    lane = hw_lane();
    unsigned char* ws = wsx;
    const int gt = gw * 64 + lane, ngt = ngw * 64;
    float* SHG = (float*)(ws + WS_SHG); const float* DHG = (const float*)(ws + WS_DHG); float* SRT = (float*)(ws + WS_SRT); float* XS5 = (float*)(ws + WS_XS5);
    const f32x2* APOW = (const f32x2*)(ws + WS_APOW);
    for (int i = gt; i < 48 * 4096; i += ngt) {
        const int bh = i >> 12, e = i & 4095, k = e >> 6; float run = 0.f;
#pragma unroll 8
        for (int s = 0; s < NSEG; ++s) { const size_t u = (size_t)bh * NSEG + s; const float sl = SHG[u * 4096 + e], d = DHG[u * 64 + k]; SHG[u * 4096 + e] = run; run = d * run + sl; }
        a.out[O_HGP + ((size_t)layer * 48 + bh) * 4096 + e] = run;
    }
    for (int i = gt; i < 48 * 2048; i += ngt) {
        const int bh = i >> 11, e = i & 2047, h = bh % 6; float run = 0.f;
        const float d = __expf(64.f * log1pf(-exp2f(-5.f - (float)h)));
#pragma unroll 8
        for (int s = 0; s < NSEG; ++s) { const size_t u = (size_t)bh * NSEG + s; const float sl = SRT[u * 2048 + e]; SRT[u * 2048 + e] = run; run = d * run + sl; }
        a.out[O_RTP + ((size_t)layer * 48 + bh) * 2048 + e] = run;
    }
    for (int i = gt; i < 128 * 64; i += ngt) {
        const int bg = i >> 6, n = i & 63, g = bg & 15; const f32x2 a64 = APOW[(size_t)((layer * 16 + g) * 17 + 16) * 64 + n];
        float rr = 0.f, ri = 0.f;
#pragma unroll 8
        for (int s = 0; s < NSEG; ++s) { float* p = XS5 + ((size_t)bg * NSEG + s) * 128; const float lr = p[n], li = p[64 + n]; p[n] = rr; p[64 + n] = ri;
            const float nr = a64[0] * rr - a64[1] * ri + lr, ni = a64[0] * ri + a64[1] * rr + li; rr = nr; ri = ni; }
        a.out[O_S5RP + ((size_t)layer * 128 + bg) * 64 + n] = rr; a.out[O_S5IP + ((size_t)layer * 128 + bg) * 64 + n] = ri;
    }
    const bf16_t* PROJ = (const bf16_t*)(ws + WS_PROJ); bf16_t* MIX = (bf16_t*)(ws + WS_MIX); bf16_t* Y5 = (bf16_t*)(ws + WS_Y5);
    const f32x2* ROPE = (const f32x2*)(ws + WS_ROPE);
    for (int u = gw; u < 768 + 768 + 2048; u += ngw) {
        if (u < 768) {
            const int b = u / 6, h = u % 6; const bf16_t* pr = PROJ + (size_t)(NP + b) * INP;
            const float lb = ((const float*)(ws + WS_LB))[layer * 384 + h * 64 + lane], oml = 1.f - lb;
            float z = bf2f(pr[C_HF + h * 64 + lane]); z = fminf(fmaxf(z, -30.f), 30.f);
            const float e = __expf(-z), sg = rcpf(1.f + e), fk = lb + oml * sg, kk = oml * e * sg, qk = siluf(bf2f(pr[C_HQ + h * 64 + lane]));
            const float vv = bf2f(pr[C_HI + h * 64 + lane]);
            const float* s0 = a.in[2] + (((size_t)layer * 128 + b) * 6 + h) * 4096; float* s1 = a.out + O_HGS + (((size_t)layer * 128 + b) * 6 + h) * 4096;
            float o = 0.f;
#pragma unroll 8
            for (int k = 0; k < 64; ++k) { const float f = rdlane(fk, k), kv = rdlane(kk, k), q = rdlane(qk, k); const float s = f * s0[k * 64 + lane] + kv * vv; s1[k * 64 + lane] = s; o += q * s; }
            const float ss = wave_sum(o * o) * (1.f / 64.f);
            const float gte = siluf(bf2f(pr[C_HGG + h * 64 + lane]));
            MIX[(size_t)(NP + b) * DM + h * 64 + lane] = f2bf1(o * rsqrtf(ss + LN_EPS) * a.in[8][layer * 64 + lane] * gte);
        } else if (u < 1536) {
            const int v_ = u - 768, b = v_ / 6, h = v_ % 6; const bf16_t* pr = PROJ + (size_t)(NP + b) * INP;
            const float gam = 1.f - exp2f(-5.f - (float)h);
            const int kl = lane & 31, i = kl & 15; const bool lo = kl < 16; const f32x2 cs = ROPE[2048 * 16 + i];
            const float xk = bf2f(pr[C_RK + h * 32 + kl]), xkp = bf2f(pr[C_RK + h * 32 + (kl ^ 16)]);
            const float xq = bf2f(pr[C_RQ + h * 32 + kl]), xqp = bf2f(pr[C_RQ + h * 32 + (kl ^ 16)]);
            const float kk = (lo ? xk * cs[0] - xkp * cs[1] : xkp * cs[1] + xk * cs[0]) * 0.17677669529663687f;
            const float qk = lo ? xq * cs[0] - xqp * cs[1] : xqp * cs[1] + xq * cs[0];
            const float vv = bf2f(pr[C_RV + h * 64 + lane]);
            const float* s0 = a.in[3] + (((size_t)layer * 128 + b) * 6 + h) * 2048; float* s1 = a.out + O_RTS + (((size_t)layer * 128 + b) * 6 + h) * 2048;
            float o = 0.f;
#pragma unroll 8
            for (int k = 0; k < 32; ++k) { const float kv = rdlane(kk, k), q = rdlane(qk, k); const float s = gam * s0[k * 64 + lane] + kv * vv; s1[k * 64 + lane] = s; o += q * s; }
            const float mu = wave_sum(o) * (1.f / 64.f), d = o - mu, var = wave_sum(d * d) * (1.f / 64.f);
            const float gte = siluf(bf2f(pr[C_RG + h * 64 + lane]));
            MIX[(size_t)(NP + b) * DM + 384 + h * 64 + lane] = f2bf1(d * rsqrtf(var + LN_EPS) * a.in[9][layer * 384 + h * 64 + lane] * gte);
        } else {
            const int v_ = u - 1536, b = v_ >> 4, g = v_ & 15, lgi = layer * 16 + g; const bf16_t* pr = PROJ + (size_t)(NP + b) * INP;
            const f32x2 gt_ = ((const f32x2*)(ws + WS_GT))[lgi * 64 + lane], ab = APOW[(size_t)(lgi * 17) * 64 + lane];
            const float* bre = a.in[13] + ((size_t)lgi * 64 + lane) * 16; const float* bim = a.in[14] + ((size_t)lgi * 64 + lane) * 16;
            float uu[16], bur = 0.f, bui = 0.f;
#pragma unroll
            for (int c = 0; c < 16; ++c) { uu[c] = bf2f(pr[C_SU + g * 16 + c]); const float br = bre[c], bi = bim[c]; bur += (gt_[0] * br - gt_[1] * bi) * uu[c]; bui += (gt_[0] * bi + gt_[1] * br) * uu[c]; }
            const size_t so = (((size_t)layer * 128 + b) * 16 + g) * 64 + lane;
            const float x0r = a.in[4][so], x0i = a.in[5][so];
            const float x1r = ab[0] * x0r - ab[1] * x0i + bur, x1i = ab[0] * x0i + ab[1] * x0r + bui;
            a.out[O_S5RS + so] = x1r; a.out[O_S5IS + so] = x1i;
            float ymine = 0.f;
#pragma unroll
            for (int c = 0; c < 16; ++c) {
                const float cr = a.in[15][((size_t)lgi * 16 + c) * 64 + lane], ci = a.in[16][((size_t)lgi * 16 + c) * 64 + lane];
                const float y = wave_sum(cr * x1r - ci * x1i) + a.in[17][layer * 256 + g * 16 + c] * uu[c];
                if (lane == c) ymine = y;
            }
            if (lane < 16) { const float x = ymine; Y5[(size_t)(NP + b) * 256 + g * 16 + lane] = f2bf1(x * rcpf(1.f + __expf(-1.5957691216057308f * (x + 0.044715f * x * x * x)))); }
        }
    }
}

__global__ void __launch_bounds__(512, 2) fwd_megakernel(Args args) {
    extern __shared__ __attribute__((aligned(16))) unsigned char lds_raw[];
    cg::grid_group grid = cg::this_grid();
    LAS unsigned char* lds = (LAS unsigned char*)lds_raw;
    const int wave = __builtin_amdgcn_readfirstlane((int)threadIdx.x >> 6); const int lane = 0;
    const int G = gridDim.x, gw = blockIdx.x * 8 + wave, ngw = G * 8;
    unsigned char* const ws0 = args.ws;

#ifndef NO_PRO
    prologue(args, lds, wave, lane, gw, ngw);
#endif
    grid.sync();

    for (int l = 0; l < DEPTH; ++l) {
#define LP() int lp = l; asm volatile("" : "+s"(lp)); int wv = wave; asm volatile("" : "+s"(wv)); int bx = blockIdx.x; asm volatile("" : "+s"(bx)); int Gp = G; asm volatile("" : "+s"(Gp)); unsigned char* ws = ws0; asm volatile("" : "+s"(ws)); \
    bf16_t* XB = (bf16_t*)(ws + WS_XB); bf16_t* PROJ = (bf16_t*)(ws + WS_PROJ); bf16_t* MIX = (bf16_t*)(ws + WS_MIX); bf16_t* HID = (bf16_t*)(ws + WS_HID); bf16_t* Y5 = (bf16_t*)(ws + WS_Y5); (void)XB; (void)PROJ; (void)MIX; (void)HID; (void)Y5
        {
            LP(); const bf16_t* WIN = (const bf16_t*)(ws + WS_WIN) + (size_t)lp * INP * DM;
            pg8::Gemm g{XB, WIN, NP, INP, DM}; pg8::StaticOrder S; S.init(NP, INP, Gp, bx);
            EpiBf<0> E{PROJ, INP, 0, nullptr, nullptr};
#ifndef NO_GEMM
            pg8::gemm_phase<EpiBf<0>, pg8::StaticOrder, true, true>(lds, g, S, E, wv);
#endif
#ifndef NO_SG
            sample_gemm(XB, WIN, INW, DM, E, wv, bx, Gp);
#endif
        }
        grid.sync();
        { LP(); mixer_pass<false>(args, ws, lds, wv, lane, bx * 8 + wv, Gp * 8, lp); }
        grid.sync();

#ifndef NO_PB
        { LP(); mixer_pass_b(args, ws, wv, lane, bx * 8 + wv, Gp * 8, lp); }
#endif

        grid.sync();
        { LP(); mixer_pass<true>(args, ws, lds, wv, lane, bx * 8 + wv, Gp * 8, lp); }
        grid.sync();
        {
            LP(); const bf16_t* WGLU = (const bf16_t*)(ws + WS_WGLU) + (size_t)lp * 256 * 256;
            pg8::Gemm g{Y5, WGLU, NP, 256, 256}; pg8::StaticOrder S; S.init(NP, 256, Gp, bx);
            EpiBf<3> E{MIX, DM, 768, Y5, args.in[19] + lp * 256};
#ifndef NO_GEMM
            pg8::gemm_phase<EpiBf<3>, pg8::StaticOrder, true, true>(lds, g, S, E, wv);
#endif
#ifndef NO_SG
            sample_gemm(Y5, WGLU, 256, 256, E, wv, bx, Gp);
#endif
        }
        grid.sync();
        {
            LP(); const bf16_t* WOUT = (const bf16_t*)(ws + WS_WOUT) + (size_t)lp * DM * DM;
            pg8::Gemm g{MIX, WOUT, NP, DM, DM}; pg8::StaticOrder S; S.init(NP, DM, Gp, bx);
            EpiRes E{lp == 0 ? args.in[0] : args.out, args.out, lp == 0 ? args.in[1] : args.out + O_YS, args.out + O_YS};
#ifndef NO_GEMM
            pg8::gemm_phase<EpiRes, pg8::StaticOrder, true, true>(lds, g, S, E, wv);
#endif
#ifndef NO_SG
            sample_gemm(MIX, WOUT, DM, DM, E, wv, bx, Gp);
#endif
        }
        grid.sync();
        { LP(); ln_phase(args.out, args.in[21] + lp * DM, args.in[22] + lp * DM, XB, lane, bx * 8 + wv, Gp * 8); }
        grid.sync();
        {
            LP(); const bf16_t* WUP = (const bf16_t*)(ws + WS_WUP) + (size_t)lp * FF * DM;
            pg8::Gemm g{XB, WUP, NP, FF, DM}; pg8::StaticOrder S; S.init(NP, FF, Gp, bx);
            EpiBf<2> E{HID, FF, 0, nullptr, nullptr};
#ifndef NO_GEMM
            pg8::gemm_phase<EpiBf<2>, pg8::StaticOrder, true, true>(lds, g, S, E, wv);
#endif
#ifndef NO_SG
            sample_gemm(XB, WUP, FF, DM, E, wv, bx, Gp);
#endif
        }
        grid.sync();
        {
            LP(); const bf16_t* WDN = (const bf16_t*)(ws + WS_WDN) + (size_t)lp * DM * FF;
            pg8::Gemm g{HID, WDN, NP, DM, FF}; pg8::StaticOrder S; S.init(NP, DM, Gp, bx);
            EpiRes E{args.out, args.out, args.out + O_YS, args.out + O_YS};
#ifndef NO_GEMM
            pg8::gemm_phase<EpiRes, pg8::StaticOrder, true, true>(lds, g, S, E, wv);
#endif
#ifndef NO_SG
            sample_gemm(HID, WDN, DM, FF, E, wv, bx, Gp);
#endif
        }
        grid.sync();
        { LP(); ln_phase(args.out, args.in[25] + lp * DM, args.in[26] + lp * DM, XB, lane, bx * 8 + wv, Gp * 8); }
        if (l + 1 < DEPTH) grid.sync();
#undef LP
    }
}

extern "C" void kernel_launch(void* const* d_in, const int* in_sizes, int n_in, void* d_out, int out_size, void* d_ws, size_t ws_size, hipStream_t stream) {
    static int grid = 0;
    if (grid == 0) {
        int dev = 0, cus = 0, per_cu = 0;
        hipGetDevice(&dev);
        hipDeviceGetAttribute(&cus, hipDeviceAttributeMultiprocessorCount, dev);
        hipFuncSetAttribute((const void*)fwd_megakernel, hipFuncAttributeMaxDynamicSharedMemorySize, LDS_BYTES);
        hipOccupancyMaxActiveBlocksPerMultiprocessor(&per_cu, (const void*)fwd_megakernel, 512, LDS_BYTES);
        if (per_cu < 1) { fprintf(stderr, "kernel_launch: occupancy query says %d blocks per CU\n", per_cu); per_cu = 1; }
        (void)hipGetLastError();
        grid = cus;
        if (n_in != 27 || ws_size < WS_END) fprintf(stderr, "kernel_launch: unexpected n_in %d / ws_size %zu\n", n_in, ws_size);
    }
    Args a{};
    for (int i = 0; i < 27; ++i) a.in[i] = (const float*)d_in[i];
    a.out = (float*)d_out; a.ws = (unsigned char*)d_ws;
    void* kargs[] = {&a};
    hipError_t e = hipLaunchCooperativeKernel((const void*)fwd_megakernel, dim3(grid), dim3(512), kargs, LDS_BYTES, stream);
    if (e != hipSuccess) fprintf(stderr, "cooperative launch failed: %s (grid %d)\n", hipGetErrorString(e), grid);
}
```

```cpp
#include <hip/hip_runtime.h>
#include <hip/hip_cooperative_groups.h>
#include <cstdio>
#include <cstdint>
namespace cg = cooperative_groups;
namespace pg8 {
#define PG8_LAS __attribute__((address_space(3)))
typedef unsigned short bf16_t;
typedef short bf16x8 __attribute__((ext_vector_type(8)));
typedef float f32x4 __attribute__((ext_vector_type(4)));
typedef unsigned u32x4 __attribute__((ext_vector_type(4)));
constexpr int BM = 256, BK = 64, HALF = 128, HTB = HALF * BK * 2  , STAGE_BYTES = 8 * HTB, NXCD = 8, WGM = 8;

__host__ __device__ __forceinline__ int lds_byte(int r, int c) { const int st = (r >> 4) * 2 + (c >> 5), rr = r & 15, cc = c & 31, ob = rr * 64 + cc * 2; return st * 1024 + (ob ^ (((ob >> 9) & 1) << 5)); }
__host__ __device__ __forceinline__ void stage_rc(int b, int& R, int& C) { const int st = b / 1024, sb = b % 1024, swz = sb ^ (((sb >> 9) & 1) << 5); R = (st >> 1) * 16 + swz / 64; C = (st & 1) * 32 + (swz % 64) / 2; }
__host__ __device__ __forceinline__ int perm32(int rho) { const int n = rho >> 4, i = rho & 15; return 8 * (i >> 2) + 4 * n + (i & 3); }

struct Unit { int pm, pn; };
struct Gemm { const bf16_t* A; const bf16_t* Bt; int M, N, K; };

struct StaticOrder {
    int nM, nN, nwg, G, c;
    __host__ __device__ void init(int M, int N, int G_, int c_) { nM = M / BM; nN = N / BM; nwg = nM * nN; G = G_; c = c_; }
    __host__ __device__ bool next(int i, Unit& u) const {
        const long L = (long)i * G + c; if (L >= nwg) return false;
        int wgid = (int)L; { const int q = nwg / NXCD, r = nwg % NXCD, xcd = wgid % NXCD, off = wgid / NXCD; wgid = (xcd < r ? xcd * (q + 1) : r * (q + 1) + (xcd - r) * q) + off; }
        const int nig = WGM * nN, gid = wgid / nig, fm = gid * WGM, gsz = (nM - fm) < WGM ? (nM - fm) : WGM;
        u.pm = fm + ((wgid % nig) % gsz); u.pn = (wgid % nig) / gsz; return true;
    }
    __device__ __forceinline__ void a_ready(const Unit&) const {}
    __device__ __forceinline__ void done(const Unit&) const {}
};
template <class Epi, class Sched, bool ALIGN_EPI = false, bool SP2 = false>
__device__ __forceinline__ void gemm_phase(PG8_LAS unsigned char* lds, const Gemm g, const Sched& S, const Epi& E, const int wid) {
    int lane_; asm volatile("v_mbcnt_lo_u32_b32 %0, -1, 0\n\tv_mbcnt_hi_u32_b32 %0, -1, %0" : "=v"(lane_));
    const int lane = lane_, tid = wid * 64 + lane, wr = wid >> 2, wc = wid & 3, fr = lane & 15, fq = lane >> 4;
    const int K = g.K, nt = K / BK;
    unsigned voffA[2], voffB[2];
#pragma unroll
    for (int i = 0; i < 2; ++i) { int R, C; stage_rc(tid * 16 + i * 8192, R, C); const int Rb = Epi::PERM ? ((R & ~31) + perm32(R & 31)) : R;
        voffA[i] = (unsigned)(R * K + C) * 2u; voffB[i] = (unsigned)(Rb * K + C) * 2u; }
    const size_t kstep = (size_t)(BK * 2);
    const size_t hstep = (size_t)HALF * K * 2;
    const size_t tstep = 2 * hstep;
    const unsigned ldsw = (unsigned)wid * 1024u;
    const int aoff = lds_byte(wr * 64 + fr, fq * 8), boff = lds_byte(wc * 32 + fr, fq * 8);
#define PG8_SA(b, h) (((b) * 2 + (h)) * HTB)
#define PG8_SB(b, h) ((4 + (b) * 2 + (h)) * HTB)
#define PG8_STAGE(bufoff, gbase, voff) do { _Pragma("unroll") for (int _i = 0; _i < 2; ++_i) \
        __builtin_amdgcn_global_load_lds((const unsigned*)((const char*)(gbase) + (voff)[_i]), (PG8_LAS unsigned*)(lds + (bufoff) + ldsw + _i * 8192), 16, 0, 0); } while (0)
#define PG8_LDA(dst, b, h) do { _Pragma("unroll") for (int m = 0; m < 4; ++m) _Pragma("unroll") for (int k = 0; k < 2; ++k) dst[m][k] = *(const PG8_LAS bf16x8*)(lds + PG8_SA(b, h) + aoff + m * 2048 + k * 1024); } while (0)
#define PG8_LDB(dst, b, h) do { _Pragma("unroll") for (int n = 0; n < 2; ++n) _Pragma("unroll") for (int k = 0; k < 2; ++k) dst[n][k] = *(const PG8_LAS bf16x8*)(lds + PG8_SB(b, h) + boff + n * 2048 + k * 1024); } while (0)
#define PG8_MMA(ai, bj, At, Bt) do { __builtin_amdgcn_s_setprio(1); _Pragma("unroll") for (int m = 0; m < 4; ++m) _Pragma("unroll") for (int n = 0; n < 2; ++n) _Pragma("unroll") for (int k = 0; k < 2; ++k) \
        acc[ai][bj][m][n] = __builtin_amdgcn_mfma_f32_16x16x32_bf16(Bt[n][k], At[m][k], acc[ai][bj][m][n], 0, 0, 0); __builtin_amdgcn_s_setprio(0); } while (0)
#define PG8_WAIT_V(n) asm volatile("s_waitcnt vmcnt(" #n ")" ::: "memory")
#define PG8_WAIT_L(n) asm volatile("s_waitcnt lgkmcnt(" #n ")" ::: "memory")
#define PG8_BAR __builtin_amdgcn_s_barrier()
#define PG8_SCHED __builtin_amdgcn_sched_barrier(0)
    Unit cur, nxt; int ui = 0;
    if (!S.next(0, cur)) return;
    f32x4 acc[2][2][4][2];
#pragma unroll
    for (int a = 0; a < 2; ++a)
#pragma unroll
        for (int b = 0; b < 2; ++b)
#pragma unroll
            for (int m = 0; m < 4; ++m)
#pragma unroll
                for (int n = 0; n < 2; ++n) acc[a][b][m][n] = (f32x4){0.f, 0.f, 0.f, 0.f};
    bf16x8 At[4][2], B0[2][2], B1[2][2];
    const char* cA = (const char*)g.A + (size_t)cur.pm * tstep; const char* cB = (const char*)g.Bt + (size_t)cur.pn * tstep;
    S.a_ready(cur);
    if constexpr (SP2) {
        PG8_STAGE(PG8_SB(0, 0), cB, voffB); PG8_STAGE(PG8_SB(0, 1), cB + hstep, voffB); PG8_STAGE(PG8_SA(0, 0), cA, voffA); PG8_STAGE(PG8_SA(0, 1), cA + hstep, voffA);
        if (wr == 1) PG8_BAR;
        PG8_WAIT_V(2); PG8_BAR;
        PG8_STAGE(PG8_SB(1, 0), cB + kstep, voffB); PG8_STAGE(PG8_SA(1, 0), cA + kstep, voffA); PG8_STAGE(PG8_SB(1, 1), cB + hstep + kstep, voffB);
        PG8_WAIT_V(6); PG8_BAR;
    } else {
        PG8_STAGE(PG8_SB(0, 0), cB, voffB); PG8_STAGE(PG8_SA(0, 0), cA, voffA); PG8_STAGE(PG8_SB(0, 1), cB + hstep, voffB); PG8_STAGE(PG8_SA(0, 1), cA + hstep, voffA);
        if (wr == 1) PG8_BAR;
        PG8_WAIT_V(4); PG8_BAR;
        PG8_STAGE(PG8_SB(1, 0), cB + kstep, voffB); PG8_STAGE(PG8_SA(1, 0), cA + kstep, voffA); PG8_STAGE(PG8_SB(1, 1), cB + hstep + kstep, voffB);
        PG8_WAIT_V(6); PG8_BAR;
    }
    for (;;) {
        const bool has_next = S.next(ui + 1, nxt);
        const char* nA = has_next ? (const char*)g.A + (size_t)nxt.pm * tstep : cA; const char* nB = has_next ? (const char*)g.Bt + (size_t)nxt.pn * tstep : cB;
        for (int t = 0; t < nt; t += 2) {
            const bool last = (t == nt - 2);
            const char* a1 = cA + (size_t)(t + 1) * kstep;
            const char* a2 = last ? nA : cA + (size_t)(t + 2) * kstep; const char* b2 = last ? nB : cB + (size_t)(t + 2) * kstep;
            const char* a3 = a2 + kstep; const char* b3 = b2 + kstep;
            if (last && has_next) S.a_ready(nxt);
            if constexpr (SP2) {
            PG8_LDB(B0, 0, 0); PG8_LDB(B1, 0, 1); PG8_SCHED; PG8_LDA(At, 0, 0); PG8_STAGE(PG8_SA(1, 1), a1 + hstep, voffA);
            PG8_WAIT_V(8); PG8_WAIT_L(0); PG8_BAR; PG8_MMA(0, 0, At, B0); PG8_MMA(0, 1, At, B1); PG8_BAR; PG8_SCHED;
            PG8_LDA(At, 0, 1); PG8_STAGE(PG8_SB(0, 0), b2, voffB); PG8_STAGE(PG8_SB(0, 1), b2 + hstep, voffB); PG8_STAGE(PG8_SA(0, 0), a2, voffA);
            PG8_WAIT_V(8); PG8_WAIT_L(0); PG8_BAR; PG8_MMA(1, 0, At, B0); PG8_MMA(1, 1, At, B1); PG8_BAR; PG8_SCHED;
            PG8_LDB(B0, 1, 0); PG8_LDB(B1, 1, 1); PG8_SCHED; PG8_LDA(At, 1, 0); PG8_STAGE(PG8_SA(0, 1), a2 + hstep, voffA);
            PG8_WAIT_V(8); PG8_WAIT_L(0); PG8_BAR; PG8_MMA(0, 0, At, B0); PG8_MMA(0, 1, At, B1); PG8_BAR; PG8_SCHED;
            PG8_LDA(At, 1, 1); PG8_STAGE(PG8_SB(1, 0), b3, voffB); PG8_STAGE(PG8_SB(1, 1), b3 + hstep, voffB); PG8_STAGE(PG8_SA(1, 0), a3, voffA);
            PG8_WAIT_V(8); PG8_WAIT_L(0); PG8_BAR; PG8_MMA(1, 0, At, B0); PG8_MMA(1, 1, At, B1); PG8_BAR; PG8_SCHED;
            } else {
            PG8_LDB(B0, 0, 0); PG8_SCHED; PG8_LDA(At, 0, 0); PG8_STAGE(PG8_SA(1, 1), a1 + hstep, voffA);
            PG8_WAIT_L(8); PG8_BAR; PG8_WAIT_L(0); PG8_MMA(0, 0, At, B0); PG8_BAR; PG8_SCHED;
            PG8_LDB(B1, 0, 1); PG8_STAGE(PG8_SB(0, 0), b2, voffB);
            PG8_BAR; PG8_WAIT_L(0); PG8_MMA(0, 1, At, B1); PG8_BAR;
            PG8_LDA(At, 0, 1); PG8_STAGE(PG8_SA(0, 0), a2, voffA);
            PG8_BAR; PG8_WAIT_L(0); PG8_MMA(1, 0, At, B0); PG8_BAR; PG8_SCHED;
            PG8_STAGE(PG8_SB(0, 1), b2 + hstep, voffB);
            PG8_WAIT_V(6); PG8_BAR; PG8_MMA(1, 1, At, B1); PG8_BAR;
            PG8_LDB(B0, 1, 0); PG8_SCHED; PG8_LDA(At, 1, 0); PG8_STAGE(PG8_SA(0, 1), a2 + hstep, voffA);
            PG8_WAIT_L(8); PG8_BAR; PG8_WAIT_L(0); PG8_MMA(0, 0, At, B0); PG8_BAR; PG8_SCHED;
            PG8_LDB(B1, 1, 1); PG8_STAGE(PG8_SB(1, 0), b3, voffB);
            PG8_BAR; PG8_WAIT_L(0); PG8_MMA(0, 1, At, B1); PG8_BAR;
            PG8_LDA(At, 1, 1); PG8_STAGE(PG8_SA(1, 0), a3, voffA);
            PG8_BAR; PG8_WAIT_L(0); PG8_MMA(1, 0, At, B0); PG8_BAR; PG8_SCHED;
            PG8_STAGE(PG8_SB(1, 1), b3 + hstep, voffB);
            PG8_WAIT_V(6); PG8_BAR; PG8_MMA(1, 1, At, B1); PG8_BAR;
            }
        }
        if constexpr (ALIGN_EPI) { if (wr == 0) PG8_BAR; }
        if constexpr (!Epi::AFTER_DRAIN) { int l_e; asm volatile("v_mbcnt_lo_u32_b32 %0, -1, 0\n\tv_mbcnt_hi_u32_b32 %0, -1, %0" : "=v"(l_e)); const int fr_e = l_e & 15, fq_e = l_e >> 4;
            E(acc, cur, wr, wc, fr_e, fq_e); S.done(cur); }
        if (!has_next) break;
#pragma unroll
        for (int a = 0; a < 2; ++a)
#pragma unroll
            for (int b = 0; b < 2; ++b)
#pragma unroll
                for (int m = 0; m < 4; ++m)
#pragma unroll
                    for (int n = 0; n < 2; ++n) acc[a][b][m][n] = (f32x4){0.f, 0.f, 0.f, 0.f};
        cur = nxt; cA = nA; cB = nB; ++ui;
        if constexpr (ALIGN_EPI) { if (wr == 1) PG8_BAR; }
    }
    PG8_WAIT_V(0);
    if constexpr (!ALIGN_EPI) { if (wr == 0) PG8_BAR; }
    PG8_BAR;
    if constexpr (Epi::AFTER_DRAIN) { E.fused(acc, cur, wr, wc, fr, fq, lds, wid, lane); S.done(cur); }
#undef PG8_SA
#undef PG8_SB
#undef PG8_STAGE
#undef PG8_LDA
#undef PG8_LDB
#undef PG8_MMA
#undef PG8_WAIT_V
#undef PG8_WAIT_L
#undef PG8_BAR
#undef PG8_SCHED
}
}

#define LAS __attribute__((address_space(3)))
#define DEVI __device__ __forceinline__
typedef unsigned short bf16_t;
typedef short bf16x8 __attribute__((ext_vector_type(8)));
typedef short bf16x4 __attribute__((ext_vector_type(4)));
typedef float f32x4 __attribute__((ext_vector_type(4)));
typedef float f32x2 __attribute__((ext_vector_type(2)));
typedef unsigned u32x4 __attribute__((ext_vector_type(4)));
typedef unsigned u32x2 __attribute__((ext_vector_type(2)));
typedef __bf16 bf16v2 __attribute__((ext_vector_type(2)));
using pg8::Unit;

constexpr int DM = 1024, NP = 16384, NS = 128, MT = NP + NS, SEQ = 2048, NBATCH = 8, DEPTH = 4;
constexpr int INW = 2944, INP = 3072, FF = 4096;
constexpr int C_HQ = 0, C_HF = 384, C_HI = 768, C_HGG = 1152, C_RQ = 1536, C_RK = 1728, C_RV = 1920, C_RG = 2304, C_SU = 2688;
constexpr float LN_EPS = 1e-5f;
constexpr float ALPHA = 1.6817928305074290f;
constexpr int NSEG = 32, SEGL = 64;
constexpr int NU_HG = NBATCH * 6 * NSEG, NU_RT = NBATCH * 6 * NSEG, NU_S5 = NBATCH * 16 * NSEG;

constexpr size_t O_YP = 0, O_YS = 16777216, O_HGP = 16908288, O_RTP = 17694720, O_S5RP = 18087936, O_S5IP = 18120704,
                 O_HGS = 18153472, O_RTS = 30736384, O_S5RS = 37027840, O_S5IS = 37552128;
constexpr size_t MiB = 1u << 20;
constexpr size_t WS_ROPE = 0, WS_LB = 0x48000, WS_APOW = 0x50000, WS_GT = 0xE0000, WS_BB = 0xF0000, WS_CM = 0x130000;
constexpr size_t WS_WIN = 2 * MiB, WS_WOUT = 26 * MiB, WS_WUP = 34 * MiB, WS_WDN = 66 * MiB, WS_WGLU = 98 * MiB;
constexpr size_t WS_XB = 99 * MiB, WS_PROJ = 132 * MiB, WS_MIX = WS_PROJ + (size_t)MT * INP * 2, WS_HID = WS_PROJ;
constexpr size_t WS_Y5 = 262 * MiB, WS_SHG = 271 * MiB, WS_DHG = 295 * MiB, WS_SRT = 296 * MiB, WS_XS5 = 308 * MiB, WS_CTL = 310 * MiB, WS_END = 311 * MiB;
constexpr size_t CTL_ZERO_BYTES = 16384;
static_assert(WS_MIX + (size_t)MT * DM * 2 <= WS_Y5, "ws map");
constexpr int LDS_BYTES = 147456;

struct Args { const float* in[27]; float* out; unsigned char* ws; };

DEVI float bf2f(bf16_t b) { return __uint_as_float(((unsigned)b) << 16); }
DEVI unsigned pk2(float lo, float hi) { f32x2 v = {lo, hi}; bf16v2 b = __builtin_convertvector(v, bf16v2); return __builtin_bit_cast(unsigned, b); }
DEVI bf16_t f2bf1(float f) { return (bf16_t)(pk2(f, 0.f) & 0xffffu); }
DEVI bf16x4 cvt4(f32x4 v) { u32x2 w; w.x = pk2(v[0], v[1]); w.y = pk2(v[2], v[3]); return __builtin_bit_cast(bf16x4, w); }
DEVI float rcpf(float x) { return __builtin_amdgcn_rcpf(x); }
DEVI float siluf(float x) { return x * rcpf(1.f + __expf(-x)); }
template <int C> DEVI float dpp_f(float x) { return __int_as_float(__builtin_amdgcn_update_dpp(0, __float_as_int(x), C, 0xF, 0xF, false)); }
DEVI float row16_sum(float v) { v += dpp_f<0x128>(v); v += dpp_f<0x124>(v); v += dpp_f<0x122>(v); v += dpp_f<0x121>(v); return v; }
DEVI float rdlane(float v, int l) { return __int_as_float(__builtin_amdgcn_readlane(__float_as_int(v), l)); }
DEVI float wave_sum(float v) { v = row16_sum(v); return (rdlane(v, 0) + rdlane(v, 16)) + (rdlane(v, 32) + rdlane(v, 48)); }
DEVI float bperm(float v, int src) { return __int_as_float(__builtin_amdgcn_ds_bpermute(src << 2, __float_as_int(v))); }
template <int D> DEVI float dpp_shr(float x) { return __int_as_float(__builtin_amdgcn_update_dpp(0, __float_as_int(x), 0x110 + D, 0xF, 0xF, false)); }
#define MFMA16(a, b, c) __builtin_amdgcn_mfma_f32_16x16x16bf16_1k((a), (b), (c), 0, 0, 0)
#define LDSW() asm volatile("s_waitcnt lgkmcnt(0)" ::: "memory")
DEVI int hw_lane() { int l; asm volatile("v_mbcnt_lo_u32_b32 %0, -1, 0\n\tv_mbcnt_hi_u32_b32 %0, -1, %0" : "=v"(l)); return l; }

#define XB_TMO      128
#define XB_XCNT(j)  (256  + 64 * (j))
#define XB_XSUB(j)  (1280 + 64 * (j))
#define XB_XGEN(j)  (2304 + 64 * (j))
#define XB_TOP      3328
#define XB_TOPGEN   3392
#define XCD_BAR_WORDS 3456
#define XB_SPIN_CAP (1u << 18)

__device__ __forceinline__ unsigned xb_ld(unsigned* p)              { return __hip_atomic_load(p, __ATOMIC_RELAXED, __HIP_MEMORY_SCOPE_AGENT); }
__device__ __forceinline__ unsigned xb_add(unsigned* p, unsigned v) { return __hip_atomic_fetch_add(p, v, __ATOMIC_RELAXED, __HIP_MEMORY_SCOPE_AGENT); }
__device__ __forceinline__ unsigned xb_xcc_id() { return (unsigned)__builtin_amdgcn_s_getreg((3 << 11) | 20) & 0xFu; }
#define XB_SPIN(cond, bar) do { unsigned _sp = 0; while (cond) { __builtin_amdgcn_s_sleep(1); \
    if ((++_sp & 255u) == 0u) { if (xb_ld(&(bar)[XB_TMO])) break; if (_sp > XB_SPIN_CAP) { atomicAdd(&(bar)[XB_TMO], 1u); break; } } } } while (0)

struct XcdBarrier {
    unsigned* bar; unsigned x;
    volatile LAS unsigned* st;
};

__device__ __forceinline__ XcdBarrier xcd_barrier_post(unsigned* bar, volatile LAS unsigned* st, bool leader) {
    XcdBarrier b; b.bar = bar; b.x = xb_xcc_id(); b.st = st;
    if (leader) (void)xb_add(&bar[XB_XCNT(b.x)], 1u);
    return b;
}
__device__ __forceinline__ void xcd_barrier_complete(unsigned* bar, unsigned x, unsigned& nloc, unsigned& nx) {
    const unsigned G = gridDim.x * gridDim.y * gridDim.z;
    unsigned sum, cnt, mine, sp = 0u;
    for (;;) {
        sum = 0u; cnt = 0u; mine = 0u;
#pragma unroll
        for (unsigned j = 0; j < 16; ++j) { const unsigned c = xb_ld(&bar[XB_XCNT(j)]); sum += c; cnt += (c > 0u) ? 1u : 0u; mine = (j == x) ? c : mine; }
        if (sum == G) break;
        __builtin_amdgcn_s_sleep(1);
        if ((++sp & 255u) == 0u) { if (xb_ld(&bar[XB_TMO])) break; if (sp > XB_SPIN_CAP) { atomicAdd(&bar[XB_TMO], 1u); break; } }
    }
    nloc = mine > 0u ? mine : 1u; nx = cnt > 0u ? cnt : 1u;
}

__device__ __forceinline__ void xcd_barrier(const XcdBarrier& b, int wave_) {
    asm volatile("s_waitcnt vmcnt(0)" ::: "memory");
    __syncthreads();
    if (wave_ == 0 && hw_lane() == 0) {
        unsigned* bar = b.bar;
        __builtin_amdgcn_s_waitcnt(0);
        unsigned nloc = b.st[0], nx = b.st[1];
        if (nloc == 0u) { xcd_barrier_complete(bar, b.x, nloc, nx); b.st[0] = nloc; b.st[1] = nx; }
        const unsigned old = xb_add(&bar[XB_XSUB(b.x)], 1u);
        const unsigned gen = old / nloc;
        if (old + 1u == (gen + 1u) * nloc) {
            __builtin_amdgcn_fence(__ATOMIC_RELEASE, "agent");
            asm volatile("s_waitcnt vmcnt(0)" ::: "memory");
            const unsigned og = xb_add(&bar[XB_TOP], 1u);
            const unsigned tg = og / nx;
            if (og + 1u == (tg + 1u) * nx) xb_add(&bar[XB_TOPGEN], 1u);
            else XB_SPIN(xb_ld(&bar[XB_TOPGEN]) == tg, bar);
            __builtin_amdgcn_fence(__ATOMIC_ACQUIRE, "agent");
            xb_add(&bar[XB_XGEN(b.x)], 1u);
            asm volatile("s_waitcnt vmcnt(0)" ::: "memory");
        } else {
            XB_SPIN(xb_ld(&bar[XB_XGEN(b.x)]) == gen, bar);
            __builtin_amdgcn_fence(__ATOMIC_ACQUIRE, "agent");
            asm volatile("s_waitcnt vmcnt(0)" ::: "memory");
        }
    }
    __syncthreads();
}


template <int ACT> struct EpiBf {
    static constexpr bool PERM = true, AFTER_DRAIN = false;
    bf16_t* O; int ldc; int coff; const bf16_t* Y; const float* bias;
    DEVI void apply8(int row, int col, f32x4 v0, f32x4 v1) const {
        if (ACT == 2) {
#pragma unroll
            for (int i = 0; i < 4; ++i) { float a = fmaxf(v0[i], 0.f), b = fmaxf(v1[i], 0.f); v0[i] = a * a; v1[i] = b * b; }
        }
        if (ACT == 3) {
            const u32x4 yw = *(const u32x4*)(Y + (size_t)row * 256 + col);
            const f32x4 b0 = *(const f32x4*)(bias + col), b1 = *(const f32x4*)(bias + col + 4);
#pragma unroll
            for (int i = 0; i < 4; ++i) {
                const unsigned w0 = yw[i >> 1], w1 = yw[2 + (i >> 1)];
                const float y0 = (i & 1) ? __uint_as_float(w0 & 0xffff0000u) : __uint_as_float(w0 << 16);
                const float y1 = (i & 1) ? __uint_as_float(w1 & 0xffff0000u) : __uint_as_float(w1 << 16);
                v0[i] = y0 * rcpf(1.f + __expf(-(v0[i] + b0[i])));
                v1[i] = y1 * rcpf(1.f + __expf(-(v1[i] + b1[i])));
            }
        }
        u32x4 w; w.x = pk2(v0[0], v0[1]); w.y = pk2(v0[2], v0[3]); w.z = pk2(v1[0], v1[1]); w.w = pk2(v1[2], v1[3]);
        *(u32x4*)(O + (size_t)row * ldc + coff + col) = w;
    }
    DEVI void operator()(const f32x4 (&acc)[2][2][4][2], const Unit& u, int wr, int wc, int fr, int fq) const {
        const int row0 = u.pm * 256 + wr * 64 + fr, col0 = u.pn * 256 + wc * 32 + 8 * fq;
#pragma unroll
        for (int ai = 0; ai < 2; ++ai)
#pragma unroll
            for (int m = 0; m < 4; ++m)
#pragma unroll
                for (int bj = 0; bj < 2; ++bj) { apply8(row0 + ai * 128 + m * 16, col0 + bj * 128, acc[ai][bj][m][0], acc[ai][bj][m][1]); if (ACT == 3) asm volatile("" ::: "memory"); }
    }
    DEVI void elem4(int row, int col, f32x4 v) const {
        if (ACT == 2) {
#pragma unroll
            for (int i = 0; i < 4; ++i) { float a = fmaxf(v[i], 0.f); v[i] = a * a; }
        }
        if (ACT == 3) {
            const u32x2 yw = *(const u32x2*)(Y + (size_t)row * 256 + col);
            const f32x4 b0 = *(const f32x4*)(bias + col);
#pragma unroll
            for (int i = 0; i < 4; ++i) {
                const unsigned w0 = yw[i >> 1];
                const float y0 = (i & 1) ? __uint_as_float(w0 & 0xffff0000u) : __uint_as_float(w0 << 16);
                v[i] = y0 * rcpf(1.f + __expf(-(v[i] + b0[i])));
            }
        }
        u32x2 w; w.x = pk2(v[0], v[1]); w.y = pk2(v[2], v[3]);
        *(u32x2*)(O + (size_t)row * ldc + coff + col) = w;
    }
};
struct EpiRes {
    static constexpr bool PERM = false, AFTER_DRAIN = false;
    const float* base; float* out; const float* sbase; float* sout;
    DEVI void operator()(const f32x4 (&acc)[2][2][4][2], const Unit& u, int wr, int wc, int fr, int fq) const {
        const int row0 = u.pm * 256 + wr * 64 + fr, col0 = u.pn * 256 + wc * 32 + 4 * fq;
#pragma unroll
        for (int ai = 0; ai < 2; ++ai)
#pragma unroll
            for (int m = 0; m < 4; ++m) {
                const size_t ro = (size_t)(row0 + ai * 128 + m * 16) * DM;
#pragma unroll
                for (int bj = 0; bj < 2; ++bj)
#pragma unroll
                    for (int n = 0; n < 2; ++n) {
                        const size_t o = ro + col0 + bj * 128 + n * 16;
                        const f32x4 b = *(const f32x4*)(base + o);
                        *(f32x4*)(out + o) = b * ALPHA + acc[ai][bj][m][n];
                    }
                asm volatile("" ::: "memory");
            }
    }
    DEVI void elem4(int row, int col, f32x4 v) const {
        const size_t o = (size_t)(row - NP) * DM + col;
        const f32x4 b = *(const f32x4*)(sbase + o);
        *(f32x4*)(sout + o) = b * ALPHA + v;
    }
};

template <class Epi> DEVI void sample_gemm(const bf16_t* A, const bf16_t* Bt, int N, int K, const Epi& E, int wave, int bx, int Gp) {
    const int lane = hw_lane();
    const int fr = lane & 15, fq = lane >> 4;
    const bf16_t* ap = A + (size_t)(NP + wave * 16 + fr) * K + fq * 8;
    for (int u = bx; u < N / 16; u += Gp) {
        const bf16_t* bp = Bt + (size_t)(u * 16 + fr) * K + fq * 8;
        f32x4 acc = {0.f, 0.f, 0.f, 0.f};
#pragma unroll 8
        for (int k = 0; k < K; k += 32) {
            const bf16x8 a = *(const bf16x8*)(ap + k), b = *(const bf16x8*)(bp + k);
            acc = __builtin_amdgcn_mfma_f32_16x16x32_bf16(b, a, acc, 0, 0, 0);
        }
        E.elem4(NP + wave * 16 + fr, u * 16 + fq * 4, acc);
    }
}

DEVI void transpose_item(const float* W, int K, int N, bf16_t* WT, LAS float* scr, int item, int lane) {
    const int nblk = N / 32, kb = item / nblk, nb = item % nblk, k0 = 64 * kb, n0 = 32 * nb;
#pragma unroll 8
    for (int i = 0; i < 32; ++i) { const int kk = 2 * i + (lane >> 5); scr[kk * 33 + (lane & 31)] = W[(size_t)(k0 + kk) * N + n0 + (lane & 31)]; }
    LDSW();
    const int c = lane & 7;
#pragma unroll
    for (int j = 0; j < 4; ++j) { const int n = (lane >> 3) + 8 * j; const LAS float* s = scr + (8 * c) * 33 + n;
        u32x4 o; o.x = pk2(s[0 * 33], s[1 * 33]); o.y = pk2(s[2 * 33], s[3 * 33]); o.z = pk2(s[4 * 33], s[5 * 33]); o.w = pk2(s[6 * 33], s[7 * 33]);
        *(u32x4*)(WT + (size_t)(n0 + n) * K + k0 + 8 * c) = o; }
    LDSW();
}
DEVI void sincos_rev(double ang, float& s, float& c) {
    const double rev = ang * 0.15915494309189535; const float fr = (float)(rev - rint(rev));
    s = __builtin_amdgcn_sinf(fr); c = __builtin_amdgcn_cosf(fr);
}
DEVI void prologue(const Args& a, LAS unsigned char* lds, int wave, int lane, int gw, int ngw) {
    lane = hw_lane();
    unsigned char* ws = a.ws;
    LAS float* scr = (LAS float*)(lds + wave * 16384);
    constexpr int I_IN = 16 * 92, I_OUT = 16 * 32, I_UP = 16 * 128, I_DN = 64 * 32, I_GL = 4 * 8, I_L = I_IN + I_OUT + I_UP + I_DN + I_GL;
    for (int it = gw; it < DEPTH * I_L; it += ngw) {
        const int l = it / I_L; int r = it % I_L;
        if (r < I_IN) { transpose_item(a.in[6] + (size_t)l * DM * INW, DM, INW, (bf16_t*)(ws + WS_WIN) + (size_t)l * INP * DM, scr, r, lane); continue; } r -= I_IN;
        if (r < I_OUT) { transpose_item(a.in[20] + (size_t)l * DM * DM, DM, DM, (bf16_t*)(ws + WS_WOUT) + (size_t)l * DM * DM, scr, r, lane); continue; } r -= I_OUT;
        if (r < I_UP) { transpose_item(a.in[23] + (size_t)l * DM * FF, DM, FF, (bf16_t*)(ws + WS_WUP) + (size_t)l * FF * DM, scr, r, lane); continue; } r -= I_UP;
        if (r < I_DN) { transpose_item(a.in[24] + (size_t)l * FF * DM, FF, DM, (bf16_t*)(ws + WS_WDN) + (size_t)l * DM * FF, scr, r, lane); continue; } r -= I_DN;
        transpose_item(a.in[18] + (size_t)l * 256 * 256, 256, 256, (bf16_t*)(ws + WS_WGLU) + (size_t)l * 256 * 256, scr, r, lane);
    }
    bf16_t* XB = (bf16_t*)(ws + WS_XB);
    for (int row = gw; row < MT; row += ngw) {
        const float* src = row < NP ? a.in[0] + (size_t)row * DM : a.in[1] + (size_t)(row - NP) * DM;
#pragma unroll
        for (int j = 0; j < 4; ++j) { const f32x4 v = *((const f32x4*)src + lane + 64 * j); u32x2 w; w.x = pk2(v[0], v[1]); w.y = pk2(v[2], v[3]);
            *((u32x2*)(XB + (size_t)row * DM) + lane + 64 * j) = w; }
    }
    const int gt = gw * 64 + lane, ngt = ngw * 64;
    f32x2* ROPE = (f32x2*)(ws + WS_ROPE);
    for (int i = gt; i < 2049 * 16; i += ngt) {
        const int p = i >> 4, f = i & 15; const float pos = p < 2048 ? (float)p : 16384.f;
        const float inv = exp2f(-(float)f * 0.83048202372184059f);
        float s, c; sincos_rev((double)pos * (double)inv, s, c);
        ROPE[i] = (f32x2){c, s};
    }
    float* LB = (float*)(ws + WS_LB);
    for (int i = gt; i < 384; i += ngt) {
        const float l0 = a.in[7][i], l1 = a.in[7][384 + i], l2 = a.in[7][768 + i], l3 = a.in[7][1152 + i];
        const float mx = fmaxf(fmaxf(l0, l1), fmaxf(l2, l3));
        const float e0 = expf(l0 - mx), e1 = expf(l1 - mx), e2 = expf(l2 - mx), e3 = expf(l3 - mx), inv = 1.f / (e0 + e1 + e2 + e3);
        LB[i] = 0.f; LB[384 + i] = e1 * inv; LB[768 + i] = (e1 + e2) * inv; LB[1152 + i] = (e1 + e2 + e3) * inv;
    }
    f32x2* APOW = (f32x2*)(ws + WS_APOW); f32x2* GT = (f32x2*)(ws + WS_GT); bf16_t* BB = (bf16_t*)(ws + WS_BB); bf16_t* CM = (bf16_t*)(ws + WS_CM);
    for (int i = gt; i < DEPTH * 16 * 64; i += ngt) {
        const int lg = i >> 6, n = i & 63;
        const float dt = expf(a.in[10][lg]); const float are = a.in[11][i], aim = a.in[12][i];
        float abr = 0.f, abi = 0.f;
        for (int m = 1; m <= 17; ++m) {
            const int mm = m <= 16 ? m : 64;
            const float mag = expf((float)mm * dt * are); float s, c; sincos_rev((double)mm * (double)dt * (double)aim, s, c);
            APOW[(size_t)(lg * 17 + (m - 1)) * 64 + n] = (f32x2){mag * c, mag * s};
            if (m == 1) { abr = mag * c; abi = mag * s; }
        }
        const float den = are * are + aim * aim, nr = abr - 1.f;
        const float gr = (nr * are + abi * aim) / den, gi = (abi * are - nr * aim) / den;
        GT[i] = (f32x2){gr, gi};
        const float* bre = a.in[13] + (size_t)i * 16; const float* bim = a.in[14] + (size_t)i * 16;
#pragma unroll
        for (int c2 = 0; c2 < 16; c2 += 2) {
            const float r0 = bre[c2], r1 = bre[c2 + 1], i0 = bim[c2], i1 = bim[c2 + 1];
            *(unsigned*)(BB + ((size_t)lg * 128 + n) * 16 + c2) = pk2(gr * r0 - gi * i0, gr * r1 - gi * i1);
            *(unsigned*)(BB + ((size_t)lg * 128 + 64 + n) * 16 + c2) = pk2(gr * i0 + gi * r0, gr * i1 + gi * r1);
        }
    }
    for (int i = gt; i < DEPTH * 16 * 16 * 128; i += ngt) {
        const int nn = i & 127, lgc = i >> 7;
        const float v = nn < 64 ? a.in[15][(size_t)lgc * 64 + nn] : -a.in[16][(size_t)lgc * 64 + nn - 64];
        CM[i] = f2bf1(v);
    }
}

DEVI void ln_phase(float* xf, const float* w, const float* b, bf16_t* xb, int lane, int gw, int ngw) {
    lane = hw_lane();
    for (int row = gw; row < MT; row += ngw) {
        f32x4* xr = (f32x4*)(xf + (size_t)row * DM) + lane;
        f32x4 v[4]; float s = 0.f;
#pragma unroll
        for (int j = 0; j < 4; ++j) { v[j] = xr[64 * j]; s += (v[j][0] + v[j][1]) + (v[j][2] + v[j][3]); }
        const float mean = wave_sum(s) * (1.f / DM); float s2 = 0.f;
#pragma unroll
        for (int j = 0; j < 4; ++j) { v[j] = v[j] - mean; s2 += (v[j][0] * v[j][0] + v[j][1] * v[j][1]) + (v[j][2] * v[j][2] + v[j][3] * v[j][3]); }
        const float rstd = 1.f / sqrtf(wave_sum(s2) * (1.f / DM) + LN_EPS);
#pragma unroll
        for (int j = 0; j < 4; ++j) {
            const f32x4 wv = *((const f32x4*)w + lane + 64 * j), bv = *((const f32x4*)b + lane + 64 * j);
            const f32x4 o = v[j] * rstd * wv + bv;
            xr[64 * j] = o;
            u32x2 pw; pw.x = pk2(o[0], o[1]); pw.y = pk2(o[2], o[3]);
            *((u32x2*)(xb + (size_t)row * DM) + lane + 64 * j) = pw;
        }
    }
}

DEVI bf16x4 ld4rows(const LAS bf16_t* p) {
    const unsigned a = p[0], b = p[72], c = p[144], d = p[216];
    u32x2 w; w.x = a | (b << 16); w.y = c | (d << 16); return __builtin_bit_cast(bf16x4, w);
}
template <int DK, bool HG, bool PC>
DEVI void la_unit(const Args& a, unsigned char* wsx, LAS unsigned char* wl, int lane, int layer, int h, const bf16_t* pr0, int pos0, float* sbuf, float* dbuf, bf16_t* mix0) {
    constexpr int NKT = DK / 16;
    constexpr int QOFF = HG ? C_HQ : C_RQ, KOFF = HG ? C_HF : C_RK, VOFF = HG ? C_HI : C_RV, GOFF = HG ? C_HGG : C_RG;
    const int fr = lane & 15, fq = lane >> 4;
    LAS bf16_t* QS = (LAS bf16_t*)wl; LAS bf16_t* KS = (LAS bf16_t*)(wl + 2304); LAS bf16_t* KT = (LAS bf16_t*)(wl + 4608);
    LAS bf16_t* VR = (LAS bf16_t*)(wl + 6912); LAS bf16_t* GR = (LAS bf16_t*)(wl + 9216); LAS float* CD = (LAS float*)(wl + 11520);
    LAS bf16_t* OS = KT;
    const unsigned char* ws = wsx;
    f32x4 S[NKT][4];
#pragma unroll
    for (int kt = 0; kt < NKT; ++kt)
#pragma unroll
        for (int vt = 0; vt < 4; ++vt)
#pragma unroll
            for (int j = 0; j < 4; ++j) S[kt][vt][j] = PC ? sbuf[(kt * 16 + fq * 4 + j) * 64 + vt * 16 + fr] : 0.f;
    float btot = 0.f;
    float lb = 0.f, oml = 1.f, lg = 0.f;
    if (HG) { lb = ((const float*)(ws + WS_LB))[layer * 384 + h * 64 + lane]; oml = 1.f - lb; }
    else { lg = log1pf(-exp2f(-5.f - (float)h)); }
    const f32x2* ROPE = (const f32x2*)(ws + WS_ROPE);
    float nw[4];
#pragma unroll
    for (int vt = 0; vt < 4; ++vt) nw[vt] = HG ? a.in[8][layer * 64 + vt * 16 + fr] : a.in[9][layer * 384 + h * 64 + vt * 16 + fr];
    const int r8 = lane >> 3, c8 = lane & 7, r4 = lane >> 2, c4 = lane & 3;
    const int g64 = r8 * INP + c8 * 8, l64 = r8 * 72 + c8 * 8, g32 = r4 * INP + c4 * 8, l32 = r4 * 72 + c4 * 8;
    const int kidx = lane & 31, tp = lane >> 5, ri = kidx & 15; const bool lo = kidx < 16;
    u32x4 pz[2], pq[2], pv[2], pg[2]; f32x2 pcs[8];
#define LA_LOAD(c) do { const bf16_t* p_ = pr0 + (size_t)(c) * 16 * INP; \
        if (HG) { pz[0] = *(const u32x4*)(p_ + g64 + KOFF + h * 64); pz[1] = *(const u32x4*)(p_ + g64 + 8 * INP + KOFF + h * 64); \
                  if (PC) { pq[0] = *(const u32x4*)(p_ + g64 + QOFF + h * 64); pq[1] = *(const u32x4*)(p_ + g64 + 8 * INP + QOFF + h * 64); } } \
        else { pz[0] = *(const u32x4*)(p_ + g32 + KOFF + h * 32); if (PC) pq[0] = *(const u32x4*)(p_ + g32 + QOFF + h * 32); \
               _Pragma("unroll") for (int it = 0; it < 8; ++it) pcs[it] = ROPE[(pos0 + (c) * 16 + 2 * it + tp) * 16 + ri]; } \
        pv[0] = *(const u32x4*)(p_ + g64 + VOFF + h * 64); pv[1] = *(const u32x4*)(p_ + g64 + 8 * INP + VOFF + h * 64); \
        if (PC) { pg[0] = *(const u32x4*)(p_ + g64 + GOFF + h * 64); pg[1] = *(const u32x4*)(p_ + g64 + 8 * INP + GOFF + h * 64); } } while (0)
    LA_LOAD(0);
    for (int c = 0; c < 4; ++c) {
        if (HG) { *(LAS u32x4*)(KS + l64) = pz[0]; *(LAS u32x4*)(KS + l64 + 8 * 72) = pz[1];
                  if (PC) { *(LAS u32x4*)(QS + l64) = pq[0]; *(LAS u32x4*)(QS + l64 + 8 * 72) = pq[1]; } }
        else { *(LAS u32x4*)(KS + l32) = pz[0]; if (PC) *(LAS u32x4*)(QS + l32) = pq[0]; }
        *(LAS u32x4*)(VR + l64) = pv[0]; *(LAS u32x4*)(VR + l64 + 8 * 72) = pv[1];
        if (PC) { *(LAS u32x4*)(GR + l64) = pg[0]; *(LAS u32x4*)(GR + l64 + 8 * 72) = pg[1]; }
        f32x2 cs[8];
        if (!HG) {
#pragma unroll
            for (int it = 0; it < 8; ++it) cs[it] = pcs[it];
        }
        if (c < 3) LA_LOAD(c + 1);
        LDSW();
        if (HG) {
            float lf[16], kv[16]; float b15 = 0.f;
#pragma unroll
            for (int t = 0; t < 16; ++t) {
                float z = bf2f(KS[t * 72 + lane]); z = fminf(fmaxf(z, -30.f), 30.f);
                const float e = __expf(-z), sg = rcpf(1.f + e);
                lf[t] = __logf(lb + oml * sg); kv[t] = oml * e * sg; b15 += lf[t];
            }
            float b = 0.f;
#pragma unroll
            for (int t = 0; t < 16; ++t) {
                b += lf[t];
                if (PC) {
                    const float q = siluf(bf2f(QS[t * 72 + lane]));
                    QS[t * 72 + lane] = f2bf1(q * __expf(b));
                    KS[t * 72 + lane] = f2bf1(kv[t] * __expf(fminf(-b, 80.f)));
                }
                KT[t * 72 + lane] = f2bf1(kv[t] * __expf(b15 - b));
            }
            CD[lane] = __expf(b15); btot += b15;
        } else {
#pragma unroll
            for (int it = 0; it < 8; ++it) {
                const int t = 2 * it + tp; const float tf = (float)(t + 1);
                const float xk = bf2f(KS[t * 72 + kidx]), xkp = bf2f(KS[t * 72 + (kidx ^ 16)]);
                const float k = (lo ? xk * cs[it][0] - xkp * cs[it][1] : xkp * cs[it][1] + xk * cs[it][0]) * 0.17677669529663687f;
                float q = 0.f;
                if (PC) { const float xq = bf2f(QS[t * 72 + kidx]), xqp = bf2f(QS[t * 72 + (kidx ^ 16)]); q = lo ? xq * cs[it][0] - xqp * cs[it][1] : xqp * cs[it][1] + xq * cs[it][0]; }
                KT[t * 72 + kidx] = f2bf1(k * __expf((16.f - tf) * lg));
                if (PC) { QS[t * 72 + kidx] = f2bf1(q * __expf(tf * lg)); KS[t * 72 + kidx] = f2bf1(k * __expf(-tf * lg)); }
            }
            if (lane < 32) CD[lane] = __expf(16.f * lg);
        }
        LDSW();
        bf16x4 vf[4], ktf[NKT];
#pragma unroll
        for (int vt = 0; vt < 4; ++vt) vf[vt] = ld4rows(VR + fq * 4 * 72 + vt * 16 + fr);
#pragma unroll
        for (int kt = 0; kt < NKT; ++kt) ktf[kt] = ld4rows(KT + fq * 4 * 72 + kt * 16 + fr);
        f32x4 O[4];
        if (PC) {
            bf16x4 qf[NKT], kf[NKT];
#pragma unroll
            for (int kt = 0; kt < NKT; ++kt) { qf[kt] = *(const LAS bf16x4*)(QS + fr * 72 + kt * 16 + fq * 4); kf[kt] = *(const LAS bf16x4*)(KS + fr * 72 + kt * 16 + fq * 4); }
            f32x4 sc = {0.f, 0.f, 0.f, 0.f};
#pragma unroll
            for (int kt = 0; kt < NKT; ++kt) sc = MFMA16(kf[kt], qf[kt], sc);
#pragma unroll
            for (int j = 0; j < 4; ++j) if (fq * 4 + j > fr) sc[j] = 0.f;
            const bf16x4 pf = cvt4(sc);
#pragma unroll
            for (int vt = 0; vt < 4; ++vt) {
                f32x4 o = {0.f, 0.f, 0.f, 0.f};
#pragma unroll
                for (int kt = 0; kt < NKT; ++kt) o = MFMA16(qf[kt], cvt4(S[kt][vt]), o);
                O[vt] = MFMA16(pf, vf[vt], o);
            }
        }
#pragma unroll
        for (int kt = 0; kt < NKT; ++kt) {
            const f32x4 cd4 = *(const LAS f32x4*)(CD + kt * 16 + fq * 4);
#pragma unroll
            for (int vt = 0; vt < 4; ++vt) S[kt][vt] = MFMA16(ktf[kt], vf[vt], S[kt][vt] * cd4);
        }
        if (PC) {
            float rs[4], mu[4];
#pragma unroll
            for (int j = 0; j < 4; ++j) {
                if (HG) {
                    float ss = (O[0][j] * O[0][j] + O[1][j] * O[1][j]) + (O[2][j] * O[2][j] + O[3][j] * O[3][j]);
                    ss = row16_sum(ss); mu[j] = 0.f; rs[j] = rsqrtf(ss * (1.f / 64.f) + LN_EPS);
                } else {
                    float sm = (O[0][j] + O[1][j]) + (O[2][j] + O[3][j]); sm = row16_sum(sm); mu[j] = sm * (1.f / 64.f);
                    const float d0 = O[0][j] - mu[j], d1 = O[1][j] - mu[j], d2 = O[2][j] - mu[j], d3 = O[3][j] - mu[j];
                    float ss = (d0 * d0 + d1 * d1) + (d2 * d2 + d3 * d3); ss = row16_sum(ss); rs[j] = rsqrtf(ss * (1.f / 64.f) + LN_EPS);
                }
            }
#pragma unroll
            for (int vt = 0; vt < 4; ++vt)
#pragma unroll
                for (int j = 0; j < 4; ++j) {
                    const int t = fq * 4 + j, v = vt * 16 + fr;
                    const float gte = siluf(bf2f(GR[t * 72 + v]));
                    OS[t * 72 + v] = f2bf1((O[vt][j] - mu[j]) * rs[j] * nw[vt] * gte);
                }
            LDSW();
            bf16_t* mp = mix0 + (size_t)(c * 16 + r8) * DM + (HG ? 0 : 384) + h * 64 + c8 * 8;
            const u32x4 o0 = *(const LAS u32x4*)(OS + l64), o1 = *(const LAS u32x4*)(OS + l64 + 8 * 72);
            *(u32x4*)mp = o0; *(u32x4*)(mp + 8 * DM) = o1;
        }
    }
#undef LA_LOAD
    if (!PC) {
#pragma unroll
        for (int kt = 0; kt < NKT; ++kt)
#pragma unroll
            for (int vt = 0; vt < 4; ++vt)
#pragma unroll
                for (int j = 0; j < 4; ++j) sbuf[(kt * 16 + fq * 4 + j) * 64 + vt * 16 + fr] = S[kt][vt][j];
        if (HG) dbuf[lane] = __expf(btot);
    }
}

template <bool PC>
DEVI void s5_unit(const Args& a, unsigned char* wsx, LAS unsigned char* wl, int lane, int layer, int g, const bf16_t* pr0, float* xbuf, bf16_t* y50) {
    const int fr = lane & 15, fq = lane >> 4, lgi = layer * 16 + g;
    const unsigned char* ws = wsx;
    const bf16_t* BB = (const bf16_t*)(ws + WS_BB) + (size_t)lgi * 128 * 16;
    const bf16_t* CM = (const bf16_t*)(ws + WS_CM) + (size_t)lgi * 16 * 128;
    const f32x2* APOW = (const f32x2*)(ws + WS_APOW) + (size_t)lgi * 17 * 64;
    bf16x4 bbf[8], cmf[8];
#pragma unroll
    for (int r = 0; r < 8; ++r) bbf[r] = *(const bf16x4*)(BB + (r * 16 + fr) * 16 + fq * 4);
    if (PC) {
#pragma unroll
        for (int s = 0; s < 8; ++s) cmf[s] = *(const bf16x4*)(CM + fr * 128 + s * 16 + fq * 4);
    }
#pragma unroll
    for (int i = 0; i < 8; ++i) { const int ch = lane + 64 * i, row = ch >> 5, c16 = ch & 31;
        *(LAS u32x4*)(wl + row * 528 + c16 * 16) = *(const u32x4*)((const unsigned char*)APOW + row * 512 + c16 * 16); }
    float xnr[4][4], xni[4][4];
#pragma unroll
    for (int r = 0; r < 4; ++r)
#pragma unroll
        for (int j = 0; j < 4; ++j) {
            const int n = r * 16 + fq * 4 + j;
            xnr[r][j] = PC ? xbuf[n] : 0.f; xni[r][j] = PC ? xbuf[64 + n] : 0.f;
        }
    f32x4 dd = {0.f, 0.f, 0.f, 0.f};
    if (PC) dd = *(const f32x4*)(a.in[17] + layer * 256 + g * 16 + fq * 4);
    LDSW();
    bf16x4 ufn = *(const bf16x4*)(pr0 + (size_t)fr * INP + C_SU + g * 16 + fq * 4);
    for (int c = 0; c < 4; ++c) {
        const bf16x4 uf = ufn;
        if (c < 3) ufn = *(const bf16x4*)(pr0 + (size_t)((c + 1) * 16 + fr) * INP + C_SU + g * 16 + fq * 4);
        const f32x4 z4 = {0.f, 0.f, 0.f, 0.f};
        f32x4 xr[4], xi[4];
#pragma unroll
        for (int r = 0; r < 4; ++r) { xr[r] = MFMA16(bbf[r], uf, z4); xi[r] = MFMA16(bbf[r + 4], uf, z4); }
        int tof = fq * 32; asm volatile("" : "+v"(tof));
        f32x2 m[4][4];
#pragma unroll
        for (int r = 0; r < 4; ++r) { const f32x4 t0 = *(const LAS f32x4*)(wl + r * 128 + tof), t1 = *(const LAS f32x4*)(wl + r * 128 + tof + 16);
            m[r][0] = (f32x2){t0[0], t0[1]}; m[r][1] = (f32x2){t0[2], t0[3]}; m[r][2] = (f32x2){t1[0], t1[1]}; m[r][3] = (f32x2){t1[2], t1[3]}; }
#define S5_STEP(D) do { _Pragma("unroll") for (int r = 0; r < 4; ++r) _Pragma("unroll") for (int j = 0; j < 4; ++j) { \
            const float pr_ = dpp_shr<D>(xr[r][j]), pi_ = dpp_shr<D>(xi[r][j]); \
            xr[r][j] += m[r][j][0] * pr_ - m[r][j][1] * pi_; xi[r][j] += m[r][j][0] * pi_ + m[r][j][1] * pr_; } } while (0)
#define S5_SQ() do { _Pragma("unroll") for (int r = 0; r < 4; ++r) _Pragma("unroll") for (int j = 0; j < 4; ++j) { \
            const float mr = m[r][j][0], mi = m[r][j][1]; m[r][j][0] = mr * mr - mi * mi; m[r][j][1] = 2.f * mr * mi; } } while (0)
        S5_STEP(1); S5_SQ(); S5_STEP(2); S5_SQ(); S5_STEP(4); S5_SQ(); S5_STEP(8);
#undef S5_STEP
#undef S5_SQ
#pragma unroll
        for (int r = 0; r < 4; ++r) {
            const f32x4 t0 = *(const LAS f32x4*)(wl + fr * 528 + r * 128 + tof), t1 = *(const LAS f32x4*)(wl + fr * 528 + r * 128 + tof + 16);
            const float pwr[4] = {t0[0], t0[2], t1[0], t1[2]}, pwi[4] = {t0[1], t0[3], t1[1], t1[3]};
#pragma unroll
            for (int j = 0; j < 4; ++j) {
                xr[r][j] += pwr[j] * xnr[r][j] - pwi[j] * xni[r][j];
                xi[r][j] += pwr[j] * xni[r][j] + pwi[j] * xnr[r][j];
            }
        }
#pragma unroll
        for (int r = 0; r < 4; ++r)
#pragma unroll
            for (int j = 0; j < 4; ++j) { xnr[r][j] = bperm(xr[r][j], (lane & 48) | 15); xni[r][j] = bperm(xi[r][j], (lane & 48) | 15); }
        if (PC) {
            f32x4 y = {0.f, 0.f, 0.f, 0.f};
#pragma unroll
            for (int s = 0; s < 4; ++s) { y = MFMA16(cmf[s], cvt4(xr[s]), y); y = MFMA16(cmf[s + 4], cvt4(xi[s]), y); }
            f32x4 o;
#pragma unroll
            for (int j = 0; j < 4; ++j) {
                const float x = y[j] + dd[j] * bf2f((bf16_t)uf[j]);
                o[j] = x * rcpf(1.f + __expf(-1.5957691216057308f * (x + 0.044715f * x * x * x)));
            }
            *(bf16x4*)(y50 + (size_t)(c * 16 + fr) * 256 + g * 16 + fq * 4) = cvt4(o);
        }
    }
    if (!PC && fr == 15) {
#pragma unroll
        for (int r = 0; r < 4; ++r)
#pragma unroll
            for (int j = 0; j < 4; ++j) { const int n = r * 16 + fq * 4 + j; xbuf[n] = xnr[r][j]; xbuf[64 + n] = xni[r][j]; }
    }
}

template <bool PC>
DEVI void mixer_pass(const Args& a, unsigned char* wsx, LAS unsigned char* lds, int wave, int lane, int gw, int ngw, int layer) {
    lane = hw_lane();
    unsigned char* ws = wsx;
    const bf16_t* PROJ = (const bf16_t*)(ws + WS_PROJ); bf16_t* MIX = (bf16_t*)(ws + WS_MIX); bf16_t* Y5 = (bf16_t*)(ws + WS_Y5);
    LAS unsigned char* wl = lds + wave * 16384;
#ifndef NO_HG
    for (int u = gw; u < NU_HG; u += ngw) {
        const int seg = u & 31, bh = u >> 5, b = bh / 6, h = bh % 6; const size_t row = (size_t)b * SEQ + seg * SEGL;
        la_unit<64, true, PC>(a, ws, wl, lane, layer, h, PROJ + row * INP, seg * SEGL, (float*)(ws + WS_SHG) + (size_t)u * 4096, (float*)(ws + WS_DHG) + (size_t)u * 64, MIX + row * DM);
    }
#endif
    asm volatile("" : "+v"(lane));
#ifndef NO_RT
    for (int u = gw >= NU_HG ? gw : gw + ((NU_HG - gw + ngw - 1) / ngw) * ngw; u < NU_HG + NU_RT; u += ngw) {
        const int v = u - NU_HG, seg = v & 31, bh = v >> 5, b = bh / 6, h = bh % 6; const size_t row = (size_t)b * SEQ + seg * SEGL;
        la_unit<32, false, PC>(a, ws, wl, lane, layer, h, PROJ + row * INP, seg * SEGL, (float*)(ws + WS_SRT) + (size_t)v * 2048, nullptr, MIX + row * DM);
    }
#endif
    asm volatile("" : "+v"(lane));
#ifndef NO_S5
    for (int u = gw >= NU_HG + NU_RT ? gw : gw + ((NU_HG + NU_RT - gw + ngw - 1) / ngw) * ngw; u < NU_HG + NU_RT + NU_S5; u += ngw) {
        const int v = u - NU_HG - NU_RT, seg = v & 31, bg = v >> 5, b = bg >> 4, g = bg & 15; const size_t row = (size_t)b * SEQ + seg * SEGL;
        int ln = lane; asm volatile("" : "+v"(ln));
        s5_unit<PC>(a, ws, wl, ln, layer, g, PROJ + row * INP, (float*)(ws + WS_XS5) + (size_t)v * 128, Y5 + row * 256);
    }
#endif
}

DEVI void mixer_pass_b(const Args& a, unsigned char* wsx, int wave, int lane, int gw, int ngw, int layer) {
    lane = hw_lane();
    unsigned char* ws = wsx;
    const int gt = gw * 64 + lane, ngt = ngw * 64;
    float* SHG = (float*)(ws + WS_SHG); const float* DHG = (const float*)(ws + WS_DHG); float* SRT = (float*)(ws + WS_SRT); float* XS5 = (float*)(ws + WS_XS5);
    const f32x2* APOW = (const f32x2*)(ws + WS_APOW);
    for (int i = gt; i < 48 * 4096; i += ngt) {
        const int bh = i >> 12, e = i & 4095, k = e >> 6; float run = 0.f;
#pragma unroll 8
        for (int s = 0; s < NSEG; ++s) { const size_t u = (size_t)bh * NSEG + s; const float sl = SHG[u * 4096 + e], d = DHG[u * 64 + k]; SHG[u * 4096 + e] = run; run = d * run + sl; }
        a.out[O_HGP + ((size_t)layer * 48 + bh) * 4096 + e] = run;
    }
    for (int i = gt; i < 48 * 2048; i += ngt) {
        const int bh = i >> 11, e = i & 2047, h = bh % 6; float run = 0.f;
        const float d = __expf(64.f * log1pf(-exp2f(-5.f - (float)h)));
#pragma unroll 8
        for (int s = 0; s < NSEG; ++s) { const size_t u = (size_t)bh * NSEG + s; const float sl = SRT[u * 2048 + e]; SRT[u * 2048 + e] = run; run = d * run + sl; }
        a.out[O_RTP + ((size_t)layer * 48 + bh) * 2048 + e] = run;
    }
    for (int i = gt; i < 128 * 64; i += ngt) {
        const int bg = i >> 6, n = i & 63, g = bg & 15; const f32x2 a64 = APOW[(size_t)((layer * 16 + g) * 17 + 16) * 64 + n];
        float rr = 0.f, ri = 0.f;
#pragma unroll 8
        for (int s = 0; s < NSEG; ++s) { float* p = XS5 + ((size_t)bg * NSEG + s) * 128; const float lr = p[n], li = p[64 + n]; p[n] = rr; p[64 + n] = ri;
            const float nr = a64[0] * rr - a64[1] * ri + lr, ni = a64[0] * ri + a64[1] * rr + li; rr = nr; ri = ni; }
        a.out[O_S5RP + ((size_t)layer * 128 + bg) * 64 + n] = rr; a.out[O_S5IP + ((size_t)layer * 128 + bg) * 64 + n] = ri;
    }
    const bf16_t* PROJ = (const bf16_t*)(ws + WS_PROJ); bf16_t* MIX = (bf16_t*)(ws + WS_MIX); bf16_t* Y5 = (bf16_t*)(ws + WS_Y5);
    const f32x2* ROPE = (const f32x2*)(ws + WS_ROPE);
    for (int u = gw; u < 768 + 768 + 2048; u += ngw) {
        if (u < 768) {
            const int b = u / 6, h = u % 6; const bf16_t* pr = PROJ + (size_t)(NP + b) * INP;
            const float lb = ((const float*)(ws + WS_LB))[layer * 384 + h * 64 + lane], oml = 1.f - lb;
            float z = bf2f(pr[C_HF + h * 64 + lane]); z = fminf(fmaxf(z, -30.f), 30.f);
            const float e = __expf(-z), sg = rcpf(1.f + e), fk = lb + oml * sg, kk = oml * e * sg, qk = siluf(bf2f(pr[C_HQ + h * 64 + lane]));
            const float vv = bf2f(pr[C_HI + h * 64 + lane]);
            const float* s0 = a.in[2] + (((size_t)layer * 128 + b) * 6 + h) * 4096; float* s1 = a.out + O_HGS + (((size_t)layer * 128 + b) * 6 + h) * 4096;
            float o = 0.f;
#pragma unroll 8
            for (int k = 0; k < 64; ++k) { const float f = rdlane(fk, k), kv = rdlane(kk, k), q = rdlane(qk, k); const float s = f * s0[k * 64 + lane] + kv * vv; s1[k * 64 + lane] = s; o += q * s; }
            const float ss = wave_sum(o * o) * (1.f / 64.f);
            const float gte = siluf(bf2f(pr[C_HGG + h * 64 + lane]));
            MIX[(size_t)(NP + b) * DM + h * 64 + lane] = f2bf1(o * rsqrtf(ss + LN_EPS) * a.in[8][layer * 64 + lane] * gte);
        } else if (u < 1536) {
            const int v_ = u - 768, b = v_ / 6, h = v_ % 6; const bf16_t* pr = PROJ + (size_t)(NP + b) * INP;
            const float gam = 1.f - exp2f(-5.f - (float)h);
            const int kl = lane & 31, i = kl & 15; const bool lo = kl < 16; const f32x2 cs = ROPE[2048 * 16 + i];
            const float xk = bf2f(pr[C_RK + h * 32 + kl]), xkp = bf2f(pr[C_RK + h * 32 + (kl ^ 16)]);
            const float xq = bf2f(pr[C_RQ + h * 32 + kl]), xqp = bf2f(pr[C_RQ + h * 32 + (kl ^ 16)]);
            const float kk = (lo ? xk * cs[0] - xkp * cs[1] : xkp * cs[1] + xk * cs[0]) * 0.17677669529663687f;
            const float qk = lo ? xq * cs[0] - xqp * cs[1] : xqp * cs[1] + xq * cs[0];
            const float vv = bf2f(pr[C_RV + h * 64 + lane]);
            const float* s0 = a.in[3] + (((size_t)layer * 128 + b) * 6 + h) * 2048; float* s1 = a.out + O_RTS + (((size_t)layer * 128 + b) * 6 + h) * 2048;
            float o = 0.f;
#pragma unroll 8
            for (int k = 0; k < 32; ++k) { const float kv = rdlane(kk, k), q = rdlane(qk, k); const float s = gam * s0[k * 64 + lane] + kv * vv; s1[k * 64 + lane] = s; o += q * s; }
            const float mu = wave_sum(o) * (1.f / 64.f), d = o - mu, var = wave_sum(d * d) * (1.f / 64.f);
            const float gte = siluf(bf2f(pr[C_RG + h * 64 + lane]));
            MIX[(size_t)(NP + b) * DM + 384 + h * 64 + lane] = f2bf1(d * rsqrtf(var + LN_EPS) * a.in[9][layer * 384 + h * 64 + lane] * gte);
        } else {
            const int v_ = u - 1536, b = v_ >> 4, g = v_ & 15, lgi = layer * 16 + g; const bf16_t* pr = PROJ + (size_t)(NP + b) * INP;
            const f32x2 gt_ = ((const f32x2*)(ws + WS_GT))[lgi * 64 + lane], ab = APOW[(size_t)(lgi * 17) * 64 + lane];
            const float* bre = a.in[13] + ((size_t)lgi * 64 + lane) * 16; const float* bim = a.in[14] + ((size_t)lgi * 64 + lane) * 16;
            float uu[16], bur = 0.f, bui = 0.f;
#pragma unroll
            for (int c = 0; c < 16; ++c) { uu[c] = bf2f(pr[C_SU + g * 16 + c]); const float br = bre[c], bi = bim[c]; bur += (gt_[0] * br - gt_[1] * bi) * uu[c]; bui += (gt_[0] * bi + gt_[1] * br) * uu[c]; }
            const size_t so = (((size_t)layer * 128 + b) * 16 + g) * 64 + lane;
            const float x0r = a.in[4][so], x0i = a.in[5][so];
            const float x1r = ab[0] * x0r - ab[1] * x0i + bur, x1i = ab[0] * x0i + ab[1] * x0r + bui;
            a.out[O_S5RS + so] = x1r; a.out[O_S5IS + so] = x1i;
            float ymine = 0.f;
#pragma unroll
            for (int c = 0; c < 16; ++c) {
                const float cr = a.in[15][((size_t)lgi * 16 + c) * 64 + lane], ci = a.in[16][((size_t)lgi * 16 + c) * 64 + lane];
                const float y = wave_sum(cr * x1r - ci * x1i) + a.in[17][layer * 256 + g * 16 + c] * uu[c];
                if (lane == c) ymine = y;
            }
            if (lane < 16) { const float x = ymine; Y5[(size_t)(NP + b) * 256 + g * 16 + lane] = f2bf1(x * rcpf(1.f + __expf(-1.5957691216057308f * (x + 0.044715f * x * x * x)))); }
        }
    }
}

__global__ void __launch_bounds__(512, 2) fwd_megakernel(Args args) {
    extern __shared__ __attribute__((aligned(16))) unsigned char lds_raw[];
    cg::grid_group grid = cg::this_grid();
    LAS unsigned char* lds = (LAS unsigned char*)lds_raw;
    const int wave = __builtin_amdgcn_readfirstlane((int)threadIdx.x >> 6); const int lane = 0;
    const int G = gridDim.x, gw = blockIdx.x * 8 + wave, ngw = G * 8;
    unsigned char* const ws0 = args.ws;
    LAS unsigned* bst = (LAS unsigned*)(lds + 131072);
    if (threadIdx.x == 0) { bst[0] = 0u; bst[1] = 0u; }
    __syncthreads();
    const XcdBarrier xbar = xcd_barrier_post((unsigned*)(ws0 + WS_CTL), (volatile LAS unsigned*)bst, threadIdx.x == 0);
#define GSYNC() xcd_barrier(xbar, wave)

#ifndef NO_PRO
    prologue(args, lds, wave, lane, gw, ngw);
#endif
    grid.sync();

    for (int l = 0; l < DEPTH; ++l) {
#define LP() int lp = l; asm volatile("" : "+s"(lp)); int wv = wave; asm volatile("" : "+s"(wv)); int bx = blockIdx.x; asm volatile("" : "+s"(bx)); int Gp = G; asm volatile("" : "+s"(Gp)); unsigned char* ws = ws0; asm volatile("" : "+s"(ws)); \
    bf16_t* XB = (bf16_t*)(ws + WS_XB); bf16_t* PROJ = (bf16_t*)(ws + WS_PROJ); bf16_t* MIX = (bf16_t*)(ws + WS_MIX); bf16_t* HID = (bf16_t*)(ws + WS_HID); bf16_t* Y5 = (bf16_t*)(ws + WS_Y5); (void)XB; (void)PROJ; (void)MIX; (void)HID; (void)Y5
        {
            LP(); const bf16_t* WIN = (const bf16_t*)(ws + WS_WIN) + (size_t)lp * INP * DM;
            pg8::Gemm g{XB, WIN, NP, INP, DM}; pg8::StaticOrder S; S.init(NP, INP, Gp, bx);
            EpiBf<0> E{PROJ, INP, 0, nullptr, nullptr};
#ifndef NO_GEMM
            pg8::gemm_phase<EpiBf<0>, pg8::StaticOrder, true, true>(lds, g, S, E, wv);
#endif
#ifndef NO_SG
            sample_gemm(XB, WIN, INW, DM, E, wv, bx, Gp);
#endif
        }
        GSYNC();
        { LP(); mixer_pass<false>(args, ws, lds, wv, lane, bx * 8 + wv, Gp * 8, lp); }
        GSYNC();

#ifndef NO_PB
        { LP(); mixer_pass_b(args, ws, wv, lane, bx * 8 + wv, Gp * 8, lp); }
#endif

        GSYNC();
        { LP(); mixer_pass<true>(args, ws, lds, wv, lane, bx * 8 + wv, Gp * 8, lp); }
        GSYNC();
        {
            LP(); const bf16_t* WGLU = (const bf16_t*)(ws + WS_WGLU) + (size_t)lp * 256 * 256;
            pg8::Gemm g{Y5, WGLU, NP, 256, 256}; pg8::StaticOrder S; S.init(NP, 256, Gp, bx);
            EpiBf<3> E{MIX, DM, 768, Y5, args.in[19] + lp * 256};
#ifndef NO_GEMM
            pg8::gemm_phase<EpiBf<3>, pg8::StaticOrder, true, true>(lds, g, S, E, wv);
#endif
#ifndef NO_SG
            sample_gemm(Y5, WGLU, 256, 256, E, wv, bx, Gp);
#endif
        }
        GSYNC();
        {
            LP(); const bf16_t* WOUT = (const bf16_t*)(ws + WS_WOUT) + (size_t)lp * DM * DM;
            pg8::Gemm g{MIX, WOUT, NP, DM, DM}; pg8::StaticOrder S; S.init(NP, DM, Gp, bx);
            EpiRes E{lp == 0 ? args.in[0] : args.out, args.out, lp == 0 ? args.in[1] : args.out + O_YS, args.out + O_YS};
#ifndef NO_GEMM
            pg8::gemm_phase<EpiRes, pg8::StaticOrder, true, true>(lds, g, S, E, wv);
#endif
#ifndef NO_SG
            sample_gemm(MIX, WOUT, DM, DM, E, wv, bx, Gp);
#endif
        }
        GSYNC();
        { LP(); ln_phase(args.out, args.in[21] + lp * DM, args.in[22] + lp * DM, XB, lane, bx * 8 + wv, Gp * 8); }
        GSYNC();
        {
            LP(); const bf16_t* WUP = (const bf16_t*)(ws + WS_WUP) + (size_t)lp * FF * DM;
            pg8::Gemm g{XB, WUP, NP, FF, DM}; pg8::StaticOrder S; S.init(NP, FF, Gp, bx);
            EpiBf<2> E{HID, FF, 0, nullptr, nullptr};
#ifndef NO_GEMM
            pg8::gemm_phase<EpiBf<2>, pg8::StaticOrder, true, true>(lds, g, S, E, wv);
#endif
#ifndef NO_SG
            sample_gemm(XB, WUP, FF, DM, E, wv, bx, Gp);
#endif
        }
        GSYNC();
        {
            LP(); const bf16_t* WDN = (const bf16_t*)(ws + WS_WDN) + (size_t)lp * DM * FF;
            pg8::Gemm g{HID, WDN, NP, DM, FF}; pg8::StaticOrder S; S.init(NP, DM, Gp, bx);
            EpiRes E{args.out, args.out, args.out + O_YS, args.out + O_YS};
#ifndef NO_GEMM
            pg8::gemm_phase<EpiRes, pg8::StaticOrder, true, true>(lds, g, S, E, wv);
#endif
#ifndef NO_SG
            sample_gemm(HID, WDN, DM, FF, E, wv, bx, Gp);
#endif
        }
        GSYNC();
        { LP(); ln_phase(args.out, args.in[25] + lp * DM, args.in[26] + lp * DM, XB, lane, bx * 8 + wv, Gp * 8); }
        if (l + 1 < DEPTH) GSYNC();
#undef LP
    }
}

extern "C" void kernel_launch(void* const* d_in, const int* in_sizes, int n_in, void* d_out, int out_size, void* d_ws, size_t ws_size, hipStream_t stream) {
    static int grid = 0;
    if (grid == 0) {
        int dev = 0, cus = 0, per_cu = 0;
        hipGetDevice(&dev);
        hipDeviceGetAttribute(&cus, hipDeviceAttributeMultiprocessorCount, dev);
        hipFuncSetAttribute((const void*)fwd_megakernel, hipFuncAttributeMaxDynamicSharedMemorySize, LDS_BYTES);
        hipOccupancyMaxActiveBlocksPerMultiprocessor(&per_cu, (const void*)fwd_megakernel, 512, LDS_BYTES);
        if (per_cu < 1) { fprintf(stderr, "kernel_launch: occupancy query says %d blocks per CU\n", per_cu); per_cu = 1; }
        (void)hipGetLastError();
        grid = cus;
        if (n_in != 27 || ws_size < WS_END) fprintf(stderr, "kernel_launch: unexpected n_in %d / ws_size %zu\n", n_in, ws_size);
    }
    (void)hipMemsetAsync((unsigned char*)d_ws + WS_CTL, 0, CTL_ZERO_BYTES, stream);
    Args a{};
    for (int i = 0; i < 27; ++i) a.in[i] = (const float*)d_in[i];
    a.out = (float*)d_out; a.ws = (unsigned char*)d_ws;
    void* kargs[] = {&a};
    hipError_t e = hipLaunchCooperativeKernel((const void*)fwd_megakernel, dim3(grid), dim3(512), kargs, LDS_BYTES, stream);
    if (e != hipSuccess) fprintf(stderr, "cooperative launch failed: %s (grid %d)\n", hipGetErrorString(e), grid);
}
```
